# Optimizing an MI355X kernel written in HIP

```python
import math
import jax, jax.numpy as jnp
from jax import lax
import numpy as np

D_MODEL = 1024
BATCH = 8
SEQ = 2048
DEPTH = 2
DEC_BATCH = 128
DEC_SEQ = 1
PAST_LEN = 16384
PAGE_SIZE = 128

N_A_LAYERS = (DEPTH + 1) // 2
N_C_LAYERS = DEPTH // 2
MIX_WIDTH = D_MODEL
RET_WIDTH = MIX_WIDTH // 2
RET_HEADS = 4
RET_DK = RET_WIDTH // RET_HEADS
RET_DV = RET_WIDTH // RET_HEADS
RET_CHUNK = 128
ROPE_BASE = 10000.0
LRU_WIDTH = MIX_WIDTH - RET_WIDTH
LRU_BLOCKS = 8
LRU_BW = LRU_WIDTH // LRU_BLOCKS
LRU_C = 8.0
CONV_W = 4
IN_A = 4 * RET_WIDTH + 2 * LRU_WIDTH
SG_CHUNK = 128
SG_HALF = D_MODEL
SG_GROUPS = 8
SG_GW = SG_HALF // SG_GROUPS
D_FF = ((8 * D_MODEL + 3 * 256 - 1) // (3 * 256)) * 256
EPS = 1e-6

kernel_name = "hybrid_retention_rglru_sgu_decoder_step"


def rmsnorm(x, g):
    xf = x.astype(jnp.float32)
    y = xf * lax.rsqrt(jnp.mean(xf * xf, axis=-1, keepdims=True) + EPS)
    return (y * g.astype(jnp.float32)).astype(x.dtype)


def layernorm(x, g, b):
    xf = x.astype(jnp.float32)
    xc = xf - jnp.mean(xf, axis=-1, keepdims=True)
    y = xc * lax.rsqrt(jnp.mean(xc * xc, axis=-1, keepdims=True) + EPS)
    return (y * g.astype(jnp.float32) + b.astype(jnp.float32)).astype(x.dtype)


def group_norm_heads(o, g):
    B, L, H, DV = o.shape
    of = o.astype(jnp.float32)
    xc = of - jnp.mean(of, axis=-1, keepdims=True)
    y = xc * lax.rsqrt(jnp.mean(xc * xc, axis=-1, keepdims=True) + EPS)
    return (y.reshape(B, L, H * DV) * g.astype(jnp.float32)).astype(o.dtype)


def rotary(x, pos):
    half = x.shape[-1] // 2
    inv = ROPE_BASE ** (-jnp.arange(half, dtype=jnp.float32) / half)
    ang = pos[:, None] * inv[None, :]
    cos = jnp.cos(ang)[None, :, None, :]
    sin = jnp.sin(ang)[None, :, None, :]
    xf = x.astype(jnp.float32)
    x1, x2 = xf[..., :half], xf[..., half:]
    return jnp.concatenate([x1 * cos - x2 * sin, x2 * cos + x1 * sin], axis=-1).astype(x.dtype)


def retention(q, k, v, s0):
    B, L, H, DK = q.shape
    DV = v.shape[-1]
    dt = q.dtype
    C = RET_CHUNK if L % RET_CHUNK == 0 else L
    n = L // C
    lg = jnp.log1p(-jnp.exp2(-5.0 - jnp.arange(H, dtype=jnp.float32)))
    q = q.reshape(B, n, C, H, DK) * (DK ** -0.5)
    k = k.reshape(B, n, C, H, DK)
    v = v.reshape(B, n, C, H, DV)
    idx = jnp.arange(C, dtype=jnp.float32)
    diff = idx[:, None] - idx[None, :]
    causal = diff >= 0
    dmat = jnp.where(causal[None], jnp.exp(jnp.where(causal, diff, 0.0)[None] * lg[:, None, None]), 0.0)
    scores = jnp.einsum('bnihd,bnjhd->bnhij', q, k) * dmat.astype(dt)
    inner = jnp.einsum('bnhij,bnjhe->bnihe', scores, v)
    zeta = jnp.exp((C - 1.0 - idx)[None, :] * lg[:, None]).astype(dt)
    xi = jnp.exp((idx + 1.0)[None, :] * lg[:, None]).astype(dt)
    u = jnp.einsum('bnjhd,bnjhe,hj->nbhde', k, v, zeta)
    g_chunk = jnp.exp(C * lg).astype(s0.dtype)[:, None, None]

    def step(s, u_c):
        return (g_chunk * s + u_c).astype(s.dtype), s

    s_fin, s_start = lax.scan(step, s0, u)
    cross = jnp.einsum('bnihd,nbhde,hi->bnihe', q, s_start.astype(dt), xi)
    return (inner + cross).reshape(B, L, H, DV), s_fin


def causal_conv(x, buf, w, b):
    L = x.shape[1]
    xp = jnp.concatenate([buf.astype(x.dtype), x], axis=1)
    y = b
    for j in range(CONV_W):
        y = y + xp[:, j:j + L] * w[j]
    return y, xp[:, -(CONV_W - 1):]


def rg_lru(x, h0, wa, ba, wx, bx, lam):
    B, L, W = x.shape
    xb = x.reshape(B, L, LRU_BLOCKS, LRU_BW)
    r = jax.nn.sigmoid(jnp.einsum('blnc,ncd->blnd', xb, wa).reshape(B, L, W) + ba).astype(jnp.float32)
    i = jax.nn.sigmoid(jnp.einsum('blnc,ncd->blnd', xb, wx).reshape(B, L, W) + bx).astype(jnp.float32)
    log_a = -LRU_C * r * jax.nn.softplus(-lam.astype(jnp.float32))
    a = jnp.exp(log_a)
    mult = jnp.sqrt(-jnp.expm1(2.0 * log_a))
    b_in = x.astype(jnp.float32) * i * mult
    b_in = b_in.at[:, 0].add(a[:, 0] * h0.astype(jnp.float32))

    def combine(left, right):
        a1, b1 = left
        a2, b2 = right
        return a1 * a2, a2 * b1 + b2

    _, h = lax.associative_scan(combine, (a, b_in), axis=1)
    h = h.astype(x.dtype)
    return h, h[:, -1]


def mixer_ab(h, pos, s_ret, h_lru, conv_buf, w_in, gn_g, conv_w, conv_b, wa, ba, wx, bx, lam, w_out):
    B, L, _ = h.shape
    z = h @ w_in
    q, k, v, g, xb, gb = jnp.split(
        z, [RET_WIDTH, 2 * RET_WIDTH, 3 * RET_WIDTH, 4 * RET_WIDTH, 4 * RET_WIDTH + LRU_WIDTH], axis=-1)
    q = rotary(q.reshape(B, L, RET_HEADS, RET_DK), pos)
    k = rotary(k.reshape(B, L, RET_HEADS, RET_DK), pos)
    o, s_new = retention(q, k, v.reshape(B, L, RET_HEADS, RET_DV), s_ret)
    y_a = group_norm_heads(o, gn_g) * jax.nn.silu(g)
    xc, conv_new = causal_conv(xb, conv_buf, conv_w, conv_b)
    hl, h_new = rg_lru(xc, h_lru, wa, ba, wx, bx, lam)
    y_b = hl * jax.nn.gelu(gb)
    out = jnp.concatenate([y_a, y_b], axis=-1) @ w_out
    return out, s_new, h_new, conv_new


def mixer_c(h, w_in, vg, vb, ws, bs, w_out):
    B, L, _ = h.shape
    z = jax.nn.gelu(h @ w_in)
    u, v = jnp.split(z, [SG_HALF], axis=-1)
    v = layernorm(v, vg, vb)
    C = SG_CHUNK if L >= SG_CHUNK else L
    n = L // C
    mask = jnp.tril(jnp.ones((C, C), dtype=ws.dtype))
    wm = ws[:, :C, :C] * mask
    vr = v.reshape(B, n, C, SG_GROUPS, SG_GW)
    sv = jnp.einsum('gij,bnjgd->bnigd', wm, vr) + bs[:, :C].T[:, :, None]
    out = (u * sv.reshape(B, L, SG_HALF)) @ w_out
    return out, v


def swiglu(h, wg, wu, wd):
    return (jax.nn.silu(h @ wg) * (h @ wu)) @ wd


def trunk(x, pos, s_ret, h_lru, conv_buf, norm1, norm2, norm_f, w_in_a, ret_gn, conv_w, conv_b,
          lru_wa, lru_ba, lru_wx, lru_bx, lru_lambda, w_out_a, w_in_c, sg_norm_g, sg_norm_b,
          sg_ws, sg_bs, w_out_c, ffn_wg, ffn_wu, ffn_wd):
    s_out, h_out, c_out, v_out = [], [], [], []
    for layer in range(DEPTH):
        hn = rmsnorm(x, norm1[layer])
        if layer % 2 == 0:
            a = layer // 2
            mix, s_n, h_n, c_n = mixer_ab(hn, pos, s_ret[a], h_lru[a], conv_buf[a], w_in_a[a], ret_gn[a],
                                          conv_w[a], conv_b[a], lru_wa[a], lru_ba[a], lru_wx[a],
                                          lru_bx[a], lru_lambda[a], w_out_a[a])
            s_out.append(s_n)
            h_out.append(h_n)
            c_out.append(c_n)
        else:
            c = layer // 2
            mix, v_n = mixer_c(hn, w_in_c[c], sg_norm_g[c], sg_norm_b[c], sg_ws[c], sg_bs[c], w_out_c[c])
            v_out.append(v_n)
        x = x + mix
        x = x + swiglu(rmsnorm(x, norm2[layer]), ffn_wg[layer], ffn_wu[layer], ffn_wd[layer])
    return rmsnorm(x, norm_f), jnp.stack(s_out), jnp.stack(h_out), jnp.stack(c_out), v_out


def setup_inputs(seed: int = 0) -> dict:
    key = jax.random.key(seed)
    ks = jax.random.split(key, 32)
    f32 = jnp.float32
    nrm = lambda k, shape, scale: jax.random.normal(k, shape, f32) * scale
    a0 = jax.random.uniform(ks[0], (N_A_LAYERS, LRU_WIDTH), f32, 0.9, 0.999)
    s = a0 ** (1.0 / LRU_C)
    lru_lambda = jnp.log(s) - jnp.log1p(-s)
    return {
        "x_prompt": nrm(ks[1], (BATCH, SEQ, D_MODEL), 1.0),
        "x_sample": nrm(ks[2], (DEC_BATCH, DEC_SEQ, D_MODEL), 1.0),
        "state_ret": nrm(ks[3], (N_A_LAYERS, DEC_BATCH, RET_HEADS, RET_DK, RET_DV), 1.0),
        "state_lru": nrm(ks[4], (N_A_LAYERS, DEC_BATCH, LRU_WIDTH), 0.5),
        "state_conv": nrm(ks[5], (N_A_LAYERS, DEC_BATCH, CONV_W - 1, LRU_WIDTH), 1.0),
        "norm1": 1.0 + nrm(ks[6], (DEPTH, D_MODEL), 0.02),
        "norm2": 1.0 + nrm(ks[7], (DEPTH, D_MODEL), 0.02),
        "norm_f": 1.0 + nrm(ks[8], (D_MODEL,), 0.02),
        "w_in_a": nrm(ks[9], (N_A_LAYERS, D_MODEL, IN_A), D_MODEL ** -0.5),
        "ret_gn": 1.0 + nrm(ks[10], (N_A_LAYERS, RET_WIDTH), 0.02),
        "conv_w": nrm(ks[11], (N_A_LAYERS, CONV_W, LRU_WIDTH), CONV_W ** -0.5),
        "conv_b": nrm(ks[12], (N_A_LAYERS, LRU_WIDTH), 0.02),
        "lru_wa": nrm(ks[13], (N_A_LAYERS, LRU_BLOCKS, LRU_BW, LRU_BW), LRU_BW ** -0.5),
        "lru_ba": nrm(ks[14], (N_A_LAYERS, LRU_WIDTH), 0.02),
        "lru_wx": nrm(ks[15], (N_A_LAYERS, LRU_BLOCKS, LRU_BW, LRU_BW), LRU_BW ** -0.5),
        "lru_bx": nrm(ks[16], (N_A_LAYERS, LRU_WIDTH), 0.02),
        "lru_lambda": lru_lambda,
        "w_out_a": nrm(ks[17], (N_A_LAYERS, MIX_WIDTH, D_MODEL), MIX_WIDTH ** -0.5),
        "w_in_c": nrm(ks[18], (N_C_LAYERS, D_MODEL, 2 * SG_HALF), D_MODEL ** -0.5),
        "sg_norm_g": 1.0 + nrm(ks[19], (N_C_LAYERS, SG_HALF), 0.02),
        "sg_norm_b": nrm(ks[20], (N_C_LAYERS, SG_HALF), 0.02),
        "sg_ws": nrm(ks[21], (N_C_LAYERS, SG_GROUPS, SG_CHUNK, SG_CHUNK), SG_CHUNK ** -0.5),
        "sg_bs": 1.0 + nrm(ks[22], (N_C_LAYERS, SG_GROUPS, SG_CHUNK), 0.01),
        "w_out_c": nrm(ks[23], (N_C_LAYERS, SG_HALF, D_MODEL), SG_HALF ** -0.5),
        "ffn_wg": nrm(ks[24], (DEPTH, D_MODEL, D_FF), D_MODEL ** -0.5),
        "ffn_wu": nrm(ks[25], (DEPTH, D_MODEL, D_FF), D_MODEL ** -0.5),
        "ffn_wd": nrm(ks[26], (DEPTH, D_FF, D_MODEL), D_FF ** -0.5),
    }


def reference(x_prompt, x_sample, state_ret, state_lru, state_conv, norm1, norm2, norm_f, w_in_a, ret_gn,
              conv_w, conv_b, lru_wa, lru_ba, lru_wx, lru_bx, lru_lambda, w_out_a, w_in_c, sg_norm_g,
              sg_norm_b, sg_ws, sg_bs, w_out_c, ffn_wg, ffn_wu, ffn_wd):
    bp, lp, _ = x_prompt.shape
    ls = x_sample.shape[1]
    dt = x_prompt.dtype
    pos_p = jnp.arange(lp, dtype=jnp.float32)
    pos_s = PAST_LEN + jnp.arange(ls, dtype=jnp.float32)
    ret0 = jnp.zeros((N_A_LAYERS, bp, RET_HEADS, RET_DK, RET_DV), dt)
    lru0 = jnp.zeros((N_A_LAYERS, bp, LRU_WIDTH), dt)
    conv0 = jnp.zeros((N_A_LAYERS, bp, CONV_W - 1, LRU_WIDTH), dt)
    weights = (norm1, norm2, norm_f, w_in_a, ret_gn, conv_w, conv_b, lru_wa, lru_ba, lru_wx, lru_bx,
               lru_lambda, w_out_a, w_in_c, sg_norm_g, sg_norm_b, sg_ws, sg_bs, w_out_c, ffn_wg, ffn_wu, ffn_wd)
    y_prompt, ret_prompt, lru_prompt, conv_prompt, _ = trunk(x_prompt, pos_p, ret0, lru0, conv0, *weights)
    y_sample, ret_sample, lru_sample, conv_sample, v_rows = trunk(
        x_sample, pos_s, state_ret, state_lru, state_conv, *weights)
    sgu_v_sample = jnp.stack(v_rows)
    return (y_prompt, y_sample, ret_prompt, ret_sample, lru_prompt, lru_sample, conv_prompt, conv_sample,
            sgu_v_sample)
```

```cpp
#include <hip/hip_runtime.h>
#include <hip/hip_cooperative_groups.h>
#include <cstdio>
namespace cg = cooperative_groups;

#ifndef FUSED
#define FUSED 1
#endif

typedef unsigned short u16;
typedef __attribute__((ext_vector_type(8))) short bf16x8;
typedef __attribute__((ext_vector_type(4))) float f32x4;
#define DEV __device__ __forceinline__
__device__ __forceinline__ int tidx_() { int t = threadIdx.x; asm volatile("" : "+v"(t)); return t; }
#define VT (tidx_() & 255)
#define VHALF (tidx_() >> 8)
#define VBLK ((int)(blockIdx.x * 2) + (tidx_() >> 8))
#define VGRD ((int)(gridDim.x * 2))

constexpr int D = 1024, MP = 16384, MT = 129;
constexpr float EPS = 1e-6f;

constexpr size_t O_RETP = 16908288, O_RETS = 17432576, O_LRUP = 25821184, O_LRUS = 25825280,
                 O_CONVP = 25890816, O_CONVS = 25903104, O_SGUV = 26099712;
constexpr size_t W_INA = 0;
constexpr size_t W_OUTA = W_INA + 6291456;
constexpr size_t W_GU0 = W_OUTA + 2097152;
constexpr size_t W_D0 = W_GU0 + 11534336;
constexpr size_t W_INC = W_D0 + 5767168;
constexpr size_t W_OUTC = W_INC + 4194304;
constexpr size_t W_GU1 = W_OUTC + 2097152;
constexpr size_t W_D1 = W_GU1 + 11534336;
constexpr size_t XB = W_D1 + 5767168;
constexpr size_t ZB = XB + 33816576;
constexpr size_t YBO = ZB + 101449728;
constexpr size_t SSTO = YBO + 33816576;
constexpr size_t SS0 = SSTO + 16777216;
constexpr size_t SSSZ = 1056768;
constexpr size_t LNSO = SS0 + 5 * SSSZ;
constexpr size_t LNQO = LNSO + SSSZ;
constexpr size_t ROPEC = LNQO + SSSZ;
constexpr size_t ROPES = ROPEC + 524544;
constexpr size_t AGGP = ROPES + 524544;
constexpr size_t AGGH = AGGP + 262144;
constexpr size_t BARO = AGGH + 262144;
constexpr size_t UCO = BARO + 65536;

struct P {
  const float *x_prompt, *x_sample, *state_ret, *state_lru, *state_conv;
  const float *norm1, *norm2, *norm_f, *w_in_a, *ret_gn, *conv_w, *conv_b, *lru_wa, *lru_ba, *lru_wx, *lru_bx,
      *lru_lambda, *w_out_a, *w_in_c, *sg_norm_g, *sg_norm_b, *sg_ws, *sg_bs, *w_out_c, *ffn_wg, *ffn_wu, *ffn_wd;
  float* out;
  char* ws;
};

DEV u16 f2bf(float f) {
  unsigned u = __float_as_uint(f);
  u += 0x7fffu + ((u >> 16) & 1u);
  return (u16)(u >> 16);
}
DEV unsigned pk(float a, float b) { unsigned r; asm("v_cvt_pk_bf16_f32 %0, %1, %2" : "=v"(r) : "v"(a), "v"(b)); return r; }
DEV float blo(unsigned w) { return __uint_as_float(w << 16); }
DEV float bhi(unsigned w) { return __uint_as_float(w & 0xffff0000u); }
DEV float bf(u16 h) { return __uint_as_float(((unsigned)h) << 16); }
DEV void unpack8(uint4 v, float* f) {
  f[0] = blo(v.x); f[1] = bhi(v.x); f[2] = blo(v.y); f[3] = bhi(v.y);
  f[4] = blo(v.z); f[5] = bhi(v.z); f[6] = blo(v.w); f[7] = bhi(v.w);
}
DEV uint4 pack8(const float* f) { return make_uint4(pk(f[0], f[1]), pk(f[2], f[3]), pk(f[4], f[5]), pk(f[6], f[7])); }
DEV float wave_sum(float v) {
#pragma unroll
  for (int o = 32; o; o >>= 1) v += __shfl_xor(v, o);
  return v;
}
DEV float rcpf_(float x) { return __builtin_amdgcn_rcpf(x); }
DEV float sigmoidf_(float x) { return rcpf_(1.f + __expf(-x)); }
DEV float siluf_(float x) { return x * rcpf_(1.f + __expf(-x)); }
DEV float geluf_(float x) {
  float y2 = 1.5957691216057308f * (x + 0.044715f * x * x * x);
  return x * rcpf_(1.f + __expf(-y2));
}
DEV float lgh(int h) { return log1pf(-exp2f(-5.f - (float)h)); }

DEV int toff8(int row, int chunk) { return row * 128 + ((chunk ^ ((row >> 1) & 7)) << 4); }
DEV int toff16(int row, int chunk) { return row * 256 + ((chunk ^ (row & 15)) << 4); }
DEV int xoff(int t, int ch) { return t * 256 + ((((ch >> 2) ^ (t & 15))) << 4) + ((ch & 3) << 2); }
DEV int ooff(int i, int e) { return i * 512 + ((((e >> 2) ^ (i & 31))) << 4) + ((e & 3) << 2); }

template <int KC>
DEV void mma_tile(f32x4 (&acc)[4][4], const char* sA, const char* sB, int wm, int wn, int lane) {
  const int r = lane & 15, q = lane >> 4;
#pragma unroll KC == 8 ? 2 : 1
  for (int ks = 0; ks < KC / 4; ++ks) {
    bf16x8 a[4], b[4];
#pragma unroll
    for (int i = 0; i < 4; ++i) {
      int ra = wm * 64 + i * 16 + r, rb = wn * 64 + i * 16 + r;
      if (KC == 8) {
        a[i] = *(const bf16x8*)(sA + toff8(ra, ks * 4 + q));
        b[i] = *(const bf16x8*)(sB + toff8(rb, ks * 4 + q));
      } else {
        a[i] = *(const bf16x8*)(sA + toff16(ra, ks * 4 + q));
        b[i] = *(const bf16x8*)(sB + toff16(rb, ks * 4 + q));
      }
    }
#pragma unroll
    for (int mi = 0; mi < 4; ++mi)
#pragma unroll
      for (int ni = 0; ni < 4; ++ni)
        acc[mi][ni] = __builtin_amdgcn_mfma_f32_16x16x32_bf16(b[ni], a[mi], acc[mi][ni], 0, 0, 0);
  }
}

DEV void zero_acc(f32x4 (&acc)[4][4]) {
#pragma unroll
  for (int i = 0; i < 4; ++i)
#pragma unroll
    for (int j = 0; j < 4; ++j) acc[i][j] = f32x4{0.f, 0.f, 0.f, 0.f};
}

DEV float rstd16(const float* ss, int row) {
  const float4* s = (const float4*)(ss + (size_t)row * 16);
  float4 a = s[0], b = s[1], c = s[2], d = s[3];
  float t = (a.x + a.y + a.z + a.w) + (b.x + b.y + b.z + b.w) + (c.x + c.y + c.z + c.w) + (d.x + d.y + d.z + d.w);
  return rsqrtf(t * (1.f / 1024.f) + EPS);
}
DEV float rstd16_q(const float* ss, int row, int fq) {
  const float4 a = *(const float4*)(ss + (size_t)row * 16 + fq * 4);
  float t = (a.x + a.y) + (a.z + a.w);
  t += __shfl_xor(t, 16);
  t += __shfl_xor(t, 32);
  return rsqrtf(t * (1.f / 1024.f) + EPS);
}
DEV float sum16(const float* ss, int row) {
  const float4* s = (const float4*)(ss + (size_t)row * 16);
  float4 a = s[0], b = s[1], c = s[2], d = s[3];
  return (a.x + a.y + a.z + a.w) + (b.x + b.y + b.z + b.w) + (c.x + c.y + c.z + c.w) + (d.x + d.y + d.z + d.w);
}

enum { EPI_INA = 0, EPI_RES_IN, EPI_RES, EPI_GU, EPI_INC };

struct GArgs {
  const u16* A; int lda; const u16* B; int K; int ntn; int PM; int vx, vl;
  const float* ss;
  float* ssw;
  u16* o16;
  u16* o16b;
  float* resid;
  float* lns; float* lnq;
  const GArgs* next;
  const GArgs* prev;
  int prev_in;
  unsigned* cnt;
  int skip_sample;
};

template <int EPI>
DEV void gemm_tile8(const P& p, const GArgs& g, char* smem, int tn) {
  const int tid = tidx_(), lane = tid & 63, w = tid >> 6, wm = w >> 1, wn = w & 1;
  const int r = lane & 15, q = lane >> 4;
  f32x4 acc[2][4];
#pragma unroll
  for (int i = 0; i < 2; ++i)
#pragma unroll
    for (int j = 0; j < 4; ++j) acc[i][j] = f32x4{0.f, 0.f, 0.f, 0.f};
  const u16* ga = g.A + (size_t)MP * g.lda;
  const u16* gb = EPI == EPI_GU ? g.B : g.B + (size_t)(tn * 128) * g.K;
  size_t goa[2], gob[2];
  int lof[2];
#pragma unroll
  for (int i = 0; i < 2; ++i) {
    const int R = (i * 8 + w) * 8, row = R + (lane >> 3), chunk = (lane & 7) ^ ((row >> 1) & 7);
    goa[i] = (size_t)row * g.lda + chunk * 8;
    const int brow = EPI == EPI_GU ? ((tn >> 1) * 256 + (tn & 1) * 64 + ((row >> 5) << 4) + (row & 15) + ((row >> 4) & 1) * 128) : row;
    gob[i] = (size_t)brow * g.K + chunk * 8;
    lof[i] = R * 128 + lane * 16;
  }
  const int nk = g.K >> 6;
#define T8_ISSUE(kt_) do { char* d_ = smem + ((kt_) & 3) * 32768; const u16* pa_ = ga + (kt_) * 64; const u16* pb_ = gb + (kt_) * 64; \
    _Pragma("unroll") for (int i = 0; i < 2; ++i) { \
      __builtin_amdgcn_global_load_lds((const unsigned*)(pa_ + goa[i]), (unsigned*)(d_ + lof[i]), 16, 0, 0); \
      __builtin_amdgcn_global_load_lds((const unsigned*)(pb_ + gob[i]), (unsigned*)(d_ + 16384 + lof[i]), 16, 0, 0); } } while (0)
  T8_ISSUE(0); T8_ISSUE(1); T8_ISSUE(2);
  for (int kt = 0; kt < nk; ++kt) {
    if (kt + 2 < nk) asm volatile("s_waitcnt vmcnt(8)" ::: "memory");
    else if (kt + 1 < nk) asm volatile("s_waitcnt vmcnt(4)" ::: "memory");
    else asm volatile("s_waitcnt vmcnt(0)" ::: "memory");
    __builtin_amdgcn_s_barrier();
    asm volatile("" ::: "memory");
    if (kt + 3 < nk) T8_ISSUE(kt + 3);
    const char* sA = smem + (kt & 3) * 32768; const char* sB = sA + 16384;
#pragma unroll
    for (int ks = 0; ks < 2; ++ks) {
      bf16x8 a[2], b[4];
#pragma unroll
      for (int i = 0; i < 2; ++i) a[i] = *(const bf16x8*)(sA + toff8(wm * 32 + i * 16 + r, ks * 4 + q));
#pragma unroll
      for (int i = 0; i < 4; ++i) b[i] = *(const bf16x8*)(sB + toff8(wn * 64 + i * 16 + r, ks * 4 + q));
#pragma unroll
      for (int mi = 0; mi < 2; ++mi)
#pragma unroll
        for (int ni = 0; ni < 4; ++ni)
          acc[mi][ni] = __builtin_amdgcn_mfma_f32_16x16x32_bf16(b[ni], a[mi], acc[mi][ni], 0, 0, 0);
    }
  }
#undef T8_ISSUE
  asm volatile("s_waitcnt vmcnt(0) lgkmcnt(0)" ::: "memory");
  __builtin_amdgcn_s_barrier();
#pragma unroll
  for (int mi = 0; mi < 2; ++mi) {
    const int row = MP + wm * 32 + mi * 16 + r;
    if (EPI == EPI_INA) {
      const float rs = rstd16(g.ss, row);
#pragma unroll
      for (int ni = 0; ni < 4; ++ni) {
        const int col = tn * 128 + wn * 64 + ni * 16 + q * 4;
        f32x4 v = acc[mi][ni] * rs;
        *(uint2*)(g.o16 + (size_t)row * 3072 + col) = make_uint2(pk(v[0], v[1]), pk(v[2], v[3]));
      }
    } else if (EPI == EPI_RES_IN || EPI == EPI_RES) {
      float* xo = g.resid + (size_t)row * D;
      const float* xi = xo;
      if (EPI == EPI_RES_IN) xi = row < MP ? p.x_prompt + (size_t)row * D : p.x_sample + (size_t)(row - MP) * D;
      float ssum = 0.f;
#pragma unroll
      for (int ni = 0; ni < 4; ++ni) {
        const int col = tn * 128 + wn * 64 + ni * 16 + q * 4;
        float4 o;
        if (EPI == EPI_RES_IN) o = *(const float4*)(xi + col);
        else { const uint2 t = *(const uint2*)((const u16*)(p.ws + XB) + (size_t)row * D + col); o = make_float4(blo(t.x), bhi(t.x), blo(t.y), bhi(t.y)); }
        f32x4 a = acc[mi][ni];
        o.x += a[0]; o.y += a[1]; o.z += a[2]; o.w += a[3];
        ssum += o.x * o.x + o.y * o.y + o.z * o.z + o.w * o.w;
        if (g.o16) *(uint2*)(g.o16 + (size_t)row * D + col) = make_uint2(pk(o.x, o.y), pk(o.z, o.w));
        else *(float4*)(xo + col) = o;
      }
      ssum += __shfl_xor(ssum, 16);
      ssum += __shfl_xor(ssum, 32);
      if (q == 0 && g.o16) g.ssw[(size_t)row * 16 + tn * 2 + wn] = ssum;
    } else if (EPI == EPI_GU) {
      const float rs = rstd16(g.ss, row);
#pragma unroll
      for (int pp = 0; pp < 2; ++pp) {
        f32x4 gg = acc[mi][2 * pp] * rs, uu = acc[mi][2 * pp + 1] * rs;
        float o[4];
#pragma unroll
        for (int j = 0; j < 4; ++j) o[j] = siluf_(gg[j]) * uu[j];
        const int col = tn * 64 + wn * 32 + pp * 16 + q * 4;
        *(uint2*)(g.o16 + (size_t)row * 2816 + col) = make_uint2(pk(o[0], o[1]), pk(o[2], o[3]));
      }
    } else if (EPI == EPI_INC) {
      const float rs = rstd16(g.ss, row);
      float s1 = 0.f, s2 = 0.f;
#pragma unroll
      for (int ni = 0; ni < 4; ++ni) {
        const int col = tn * 128 + wn * 64 + ni * 16 + q * 4;
        f32x4 v = acc[mi][ni] * rs;
        float o[4];
#pragma unroll
        for (int j = 0; j < 4; ++j) { o[j] = geluf_(v[j]); s1 += o[j]; s2 += o[j] * o[j]; }
        u16* dst = tn < 8 ? g.o16 + (size_t)row * D + col : g.o16b + (size_t)row * D + (col - 1024);
        *(uint2*)dst = make_uint2(pk(o[0], o[1]), pk(o[2], o[3]));
      }
      if (tn >= 8) {
        s1 += __shfl_xor(s1, 16); s1 += __shfl_xor(s1, 32);
        s2 += __shfl_xor(s2, 16); s2 += __shfl_xor(s2, 32);
        if (q == 0) {
          g.lns[(size_t)row * 16 + (tn - 8) * 2 + wn] = s1;
          g.lnq[(size_t)row * 16 + (tn - 8) * 2 + wn] = s2;
        }
      }
    }
  }
}

namespace pg8 {
#define PG8_LAS __attribute__((address_space(3)))
constexpr int BM = 256, BK = 64, HALF = 128, HTB = HALF * BK * 2, NXCD = 8, WGM = 8;
DEV int lds_byte(int r, int c) { const int st = (r >> 4) * 2 + (c >> 5), rr = r & 15, cc = c & 31, ob = rr * 64 + cc * 2; return st * 1024 + (ob ^ (((ob >> 9) & 1) << 5)); }
DEV void stage_rc(int b, int& R, int& C) { const int st = b / 1024, sb = b % 1024, swz = sb ^ (((sb >> 9) & 1) << 5); R = (st >> 1) * 16 + swz / 64; C = (st & 1) * 32 + (swz % 64) / 2; }
DEV int perm32(int rho) { const int n = rho >> 4, i = rho & 15; return 8 * (i >> 2) + 4 * n + (i & 3); }
struct Unit { int pm, pn; };
struct Gemm { const u16* A; const u16* Bt; int M, N, K; };
struct StaticOrder {
  int nM, nN, nwg, G, c;
  DEV void init(int M, int N, int G_, int c_) { nM = M / BM; nN = N / BM; nwg = nM * nN; G = G_; c = c_; }
  DEV bool next(int i, Unit& u) const {
    const long L = (long)i * G + c; if (L >= nwg) return false;
    int wgid = (int)L; { const int q = nwg / NXCD, r = nwg % NXCD, xcd = wgid % NXCD, off = wgid / NXCD; wgid = (xcd < r ? xcd * (q + 1) : r * (q + 1) + (xcd - r) * q) + off; }
    const int nig = WGM * nN, gid = wgid / nig, fm = gid * WGM, gsz = (nM - fm) < WGM ? (nM - fm) : WGM;
    u.pm = fm + ((wgid % nig) % gsz); u.pn = (wgid % nig) / gsz; return true;
  }
};
template <class Epi, class Sched>
DEV void gemm_phase(PG8_LAS unsigned char* lds, const Gemm g, const Sched& S, const Epi& E) {
  const int tid = threadIdx.x, wid = __builtin_amdgcn_readfirstlane(tid >> 6), lane = tid & 63, wr = wid >> 2, wc = wid & 3, fr = lane & 15, fq = lane >> 4;
  const int K = g.K, nt = K / BK;
  unsigned voffA[2], voffB[2];
#pragma unroll
  for (int i = 0; i < 2; ++i) { int R, C; stage_rc(tid * 16 + i * 8192, R, C); const int Rb = Epi::PERM ? ((R & ~31) + perm32(R & 31)) : R;
    voffA[i] = (unsigned)(R * K + C) * 2u; voffB[i] = (unsigned)(Rb * K + C) * 2u; }
  const size_t kstep = (size_t)(BK * 2);
  const size_t hstep = (size_t)HALF * K * 2;
  const size_t tstep = 2 * hstep;
  const unsigned ldsw = (unsigned)wid * 1024u;
  const int aoff = lds_byte(wr * 64 + fr, fq * 8), boff = lds_byte(wc * 32 + fr, fq * 8);
#define PG8_SA(b, h) (((b) * 2 + (h)) * HTB)
#define PG8_SB(b, h) ((4 + (b) * 2 + (h)) * HTB)
#define PG8_STAGE(bufoff, gbase, voff) do { _Pragma("unroll") for (int _i = 0; _i < 2; ++_i) \
    __builtin_amdgcn_global_load_lds((const unsigned*)((const char*)(gbase) + (voff)[_i]), (PG8_LAS unsigned*)(lds + (bufoff) + ldsw + _i * 8192), 16, 0, 0); } while (0)
#define PG8_LDA(dst, b, h) do { _Pragma("unroll") for (int m = 0; m < 4; ++m) _Pragma("unroll") for (int k = 0; k < 2; ++k) dst[m][k] = *(const PG8_LAS bf16x8*)(lds + PG8_SA(b, h) + aoff + m * 2048 + k * 1024); } while (0)
#define PG8_LDB(dst, b, h) do { _Pragma("unroll") for (int n = 0; n < 2; ++n) _Pragma("unroll") for (int k = 0; k < 2; ++k) dst[n][k] = *(const PG8_LAS bf16x8*)(lds + PG8_SB(b, h) + boff + n * 2048 + k * 1024); } while (0)
#define PG8_MMA(ai, bj, At, Bt) do { __builtin_amdgcn_s_setprio(1); _Pragma("unroll") for (int m = 0; m < 4; ++m) _Pragma("unroll") for (int n = 0; n < 2; ++n) _Pragma("unroll") for (int k = 0; k < 2; ++k) \
    acc[ai][bj][m][n] = __builtin_amdgcn_mfma_f32_16x16x32_bf16(Bt[n][k], At[m][k], acc[ai][bj][m][n], 0, 0, 0); __builtin_amdgcn_s_setprio(0); } while (0)
#define PG8_WAIT_V(n) asm volatile("s_waitcnt vmcnt(" #n ")" ::: "memory")
#define PG8_WAIT_L(n) asm volatile("s_waitcnt lgkmcnt(" #n ")" ::: "memory")
#define PG8_BAR __builtin_amdgcn_s_barrier()
#define PG8_SCHED __builtin_amdgcn_sched_barrier(0)
  Unit cur, nxt; int ui = 0;
  if (!S.next(0, cur)) return;
  f32x4 acc[2][2][4][2];
#pragma unroll
  for (int a = 0; a < 2; ++a)
#pragma unroll
    for (int b = 0; b < 2; ++b)
#pragma unroll
      for (int m = 0; m < 4; ++m)
#pragma unroll
        for (int n = 0; n < 2; ++n) acc[a][b][m][n] = (f32x4){0.f, 0.f, 0.f, 0.f};
  bf16x8 At[4][2], B0[2][2], B1[2][2];
  const char* cA = (const char*)g.A + (size_t)cur.pm * tstep; const char* cB = (const char*)g.Bt + (size_t)cur.pn * tstep;
  PG8_STAGE(PG8_SB(0, 0), cB, voffB); PG8_STAGE(PG8_SA(0, 0), cA, voffA); PG8_STAGE(PG8_SB(0, 1), cB + hstep, voffB); PG8_STAGE(PG8_SA(0, 1), cA + hstep, voffA);
  if (wr == 1) PG8_BAR;
  PG8_WAIT_V(4); PG8_BAR;
  PG8_STAGE(PG8_SB(1, 0), cB + kstep, voffB); PG8_STAGE(PG8_SA(1, 0), cA + kstep, voffA); PG8_STAGE(PG8_SB(1, 1), cB + hstep + kstep, voffB);
  PG8_WAIT_V(6); PG8_BAR;
  for (;;) {
    const bool has_next = S.next(ui + 1, nxt);
    const char* nA = has_next ? (const char*)g.A + (size_t)nxt.pm * tstep : cA; const char* nB = has_next ? (const char*)g.Bt + (size_t)nxt.pn * tstep : cB;
    for (int t = 0; t < nt; t += 2) {
      const bool last = (t == nt - 2);
      const char* a1 = cA + (size_t)(t + 1) * kstep;
      const char* a2 = last ? nA : cA + (size_t)(t + 2) * kstep; const char* b2 = last ? nB : cB + (size_t)(t + 2) * kstep;
      const char* a3 = a2 + kstep; const char* b3 = b2 + kstep;
      PG8_LDB(B0, 0, 0); PG8_SCHED; PG8_LDA(At, 0, 0); PG8_STAGE(PG8_SA(1, 1), a1 + hstep, voffA);
      PG8_WAIT_L(8); PG8_BAR; PG8_WAIT_L(0); PG8_MMA(0, 0, At, B0); PG8_BAR; PG8_SCHED;
      PG8_LDB(B1, 0, 1); PG8_STAGE(PG8_SB(0, 0), b2, voffB);
      PG8_BAR; PG8_WAIT_L(0); PG8_MMA(0, 1, At, B1); PG8_BAR;
      PG8_LDA(At, 0, 1); PG8_STAGE(PG8_SA(0, 0), a2, voffA);
      PG8_BAR; PG8_WAIT_L(0); PG8_MMA(1, 0, At, B0); PG8_BAR; PG8_SCHED;
      PG8_STAGE(PG8_SB(0, 1), b2 + hstep, voffB);
      PG8_WAIT_V(6); PG8_BAR; PG8_MMA(1, 1, At, B1); PG8_BAR;
      PG8_LDB(B0, 1, 0); PG8_SCHED; PG8_LDA(At, 1, 0); PG8_STAGE(PG8_SA(0, 1), a2 + hstep, voffA);
      PG8_WAIT_L(8); PG8_BAR; PG8_WAIT_L(0); PG8_MMA(0, 0, At, B0); PG8_BAR; PG8_SCHED;
      PG8_LDB(B1, 1, 1); PG8_STAGE(PG8_SB(1, 0), b3, voffB);
      PG8_BAR; PG8_WAIT_L(0); PG8_MMA(0, 1, At, B1); PG8_BAR;
      PG8_LDA(At, 1, 1); PG8_STAGE(PG8_SA(1, 0), a3, voffA);
      PG8_BAR; PG8_WAIT_L(0); PG8_MMA(1, 0, At, B0); PG8_BAR; PG8_SCHED;
      PG8_STAGE(PG8_SB(1, 1), b3 + hstep, voffB);
      PG8_WAIT_V(6); PG8_BAR; PG8_MMA(1, 1, At, B1); PG8_BAR;
    }
    E(acc, cur, ui, wr, wc, fr, fq);
    if (!has_next) break;
#pragma unroll
    for (int a = 0; a < 2; ++a)
#pragma unroll
      for (int b = 0; b < 2; ++b)
#pragma unroll
        for (int m = 0; m < 4; ++m)
#pragma unroll
          for (int n = 0; n < 2; ++n) acc[a][b][m][n] = (f32x4){0.f, 0.f, 0.f, 0.f};
    cur = nxt; cA = nA; cB = nB; ++ui;
  }
  PG8_WAIT_V(0);
  if (wr == 0) PG8_BAR;
  PG8_BAR;
#undef PG8_SA
#undef PG8_SB
#undef PG8_STAGE
#undef PG8_LDA
#undef PG8_LDB
#undef PG8_MMA
#undef PG8_WAIT_V
#undef PG8_WAIT_L
#undef PG8_BAR
#undef PG8_SCHED
}
}

template <int EPI>
struct Epi8 {
  static constexpr bool PERM = true;
  GArgs g; const P* p;
  const PG8_LAS float* rsl;
  DEV void operator()(const f32x4 (&acc)[2][2][4][2], const pg8::Unit& u, int ui, int wr, int wc, int fr, int fq) const {
    const int rbase = u.pm * 256 + wr * 64 + fr;
    float rsv[2][4];
    if (EPI == EPI_INA || EPI == EPI_GU || EPI == EPI_INC) {
#pragma unroll
      for (int ai = 0; ai < 2; ++ai)
#pragma unroll
        for (int m = 0; m < 4; ++m) rsv[ai][m] = rsl[ui * 256 + ai * 128 + wr * 64 + m * 16 + fr];
    }
#pragma unroll
    for (int ai = 0; ai < 2; ++ai) {
      if (EPI == EPI_RES_IN || EPI == EPI_RES) {
        float o[4][2][8];
        if (EPI == EPI_RES_IN) {
          float4 x4[4][2][2];
#pragma unroll
          for (int m = 0; m < 4; ++m)
#pragma unroll
            for (int bj = 0; bj < 2; ++bj) {
              const float* xp = p->x_prompt + (size_t)(rbase + ai * 128 + m * 16) * D + u.pn * 256 + bj * 128 + wc * 32 + 8 * fq;
              x4[m][bj][0] = *(const float4*)xp; x4[m][bj][1] = *(const float4*)(xp + 4);
            }
          asm volatile("s_waitcnt vmcnt(0)" ::: "memory");
#pragma unroll
          for (int m = 0; m < 4; ++m)
#pragma unroll
            for (int bj = 0; bj < 2; ++bj) {
              o[m][bj][0] = x4[m][bj][0].x; o[m][bj][1] = x4[m][bj][0].y; o[m][bj][2] = x4[m][bj][0].z; o[m][bj][3] = x4[m][bj][0].w;
              o[m][bj][4] = x4[m][bj][1].x; o[m][bj][5] = x4[m][bj][1].y; o[m][bj][6] = x4[m][bj][1].z; o[m][bj][7] = x4[m][bj][1].w;
            }
        } else {
          uint4 x8[4][2];
#pragma unroll
          for (int m = 0; m < 4; ++m)
#pragma unroll
            for (int bj = 0; bj < 2; ++bj)
              x8[m][bj] = *(const uint4*)((const u16*)(p->ws + XB) + (size_t)(rbase + ai * 128 + m * 16) * D + u.pn * 256 + bj * 128 + wc * 32 + 8 * fq);
          asm volatile("s_waitcnt vmcnt(0)" ::: "memory");
#pragma unroll
          for (int m = 0; m < 4; ++m)
#pragma unroll
            for (int bj = 0; bj < 2; ++bj) unpack8(x8[m][bj], o[m][bj]);
        }
#pragma unroll
        for (int m = 0; m < 4; ++m) {
          const int row = rbase + ai * 128 + m * 16;
          float ssum = 0.f;
#pragma unroll
          for (int bj = 0; bj < 2; ++bj) {
            const int col0 = u.pn * 256 + bj * 128 + wc * 32 + 8 * fq;
            const f32x4 a0 = acc[ai][bj][m][0], a1 = acc[ai][bj][m][1];
#pragma unroll
            for (int j = 0; j < 4; ++j) { o[m][bj][j] += a0[j]; o[m][bj][4 + j] += a1[j]; }
#pragma unroll
            for (int j = 0; j < 8; ++j) ssum += o[m][bj][j] * o[m][bj][j];
            *(uint4*)(g.o16 + (size_t)row * D + col0) = pack8(o[m][bj]);
          }
          ssum += __shfl_xor(ssum, 16);
          ssum += __shfl_xor(ssum, 32);
          if (fq == 0) g.ssw[(size_t)row * 16 + u.pn * 4 + wc] = ssum;
        }
      } else {
#pragma unroll
        for (int m = 0; m < 4; ++m) {
          const int row = rbase + ai * 128 + m * 16;
          const float rs = rsv[ai][m];
          if (EPI == EPI_INA) {
#pragma unroll
            for (int bj = 0; bj < 2; ++bj) {
              const int col0 = u.pn * 256 + bj * 128 + wc * 32 + 8 * fq;
              f32x4 v0 = acc[ai][bj][m][0] * rs, v1 = acc[ai][bj][m][1] * rs;
              *(uint4*)(g.o16 + (size_t)row * 3072 + col0) = make_uint4(pk(v0[0], v0[1]), pk(v0[2], v0[3]), pk(v1[0], v1[1]), pk(v1[2], v1[3]));
            }
          } else if (EPI == EPI_GU) {
            const f32x4 g0 = acc[ai][0][m][0] * rs, g1 = acc[ai][0][m][1] * rs, u0 = acc[ai][1][m][0] * rs, u1 = acc[ai][1][m][1] * rs;
            float o[8];
#pragma unroll
            for (int j = 0; j < 4; ++j) { o[j] = siluf_(g0[j]) * u0[j]; o[4 + j] = siluf_(g1[j]) * u1[j]; }
            const int col = u.pn * 128 + wc * 32 + 8 * fq;
            *(uint4*)(g.o16 + (size_t)row * 2816 + col) = pack8(o);
          } else if (EPI == EPI_INC) {
            float s1 = 0.f, s2 = 0.f;
#pragma unroll
            for (int bj = 0; bj < 2; ++bj) {
              const int col0 = u.pn * 256 + bj * 128 + wc * 32 + 8 * fq;
              f32x4 v0 = acc[ai][bj][m][0] * rs, v1 = acc[ai][bj][m][1] * rs;
              float o[8];
#pragma unroll
              for (int j = 0; j < 4; ++j) { o[j] = geluf_(v0[j]); o[4 + j] = geluf_(v1[j]); }
#pragma unroll
              for (int j = 0; j < 8; ++j) { s1 += o[j]; s2 += o[j] * o[j]; }
              u16* dst = u.pn < 4 ? g.o16 + (size_t)row * D + col0 : g.o16b + (size_t)row * D + (col0 - 1024);
              *(uint4*)dst = pack8(o);
            }
            if (u.pn >= 4) {
              s1 += __shfl_xor(s1, 16); s1 += __shfl_xor(s1, 32);
              s2 += __shfl_xor(s2, 16); s2 += __shfl_xor(s2, 32);
              if (fq == 0) {
                g.lns[(size_t)row * 16 + (u.pn - 4) * 4 + wc] = s1;
                g.lnq[(size_t)row * 16 + (u.pn - 4) * 4 + wc] = s2;
              }
            }
          }
        }
      }
    }
  }
};

DEV void handoff_publish(unsigned* cnt) {
  asm volatile("s_waitcnt vmcnt(0)" ::: "memory");
  __syncthreads();
  if (threadIdx.x == 0) {
    __builtin_amdgcn_fence(__ATOMIC_RELEASE, "agent");
    asm volatile("s_waitcnt vmcnt(0)" ::: "memory");
    __hip_atomic_fetch_add(cnt, 1u, __ATOMIC_RELAXED, __HIP_MEMORY_SCOPE_AGENT);
  }
  __syncthreads();
}
DEV void handoff_wait(unsigned* cnt, unsigned need) {
  if (threadIdx.x == 0) {
    unsigned sp = 0;
    while (__hip_atomic_load(cnt, __ATOMIC_RELAXED, __HIP_MEMORY_SCOPE_AGENT) < need) {
      __builtin_amdgcn_s_sleep(2);
      if (++sp > (1u << 22)) break;
    }
    __builtin_amdgcn_fence(__ATOMIC_ACQUIRE, "agent");
    asm volatile("s_waitcnt vmcnt(0)" ::: "memory");
  }
  __syncthreads();
}

template <int EPI>
__device__ void gemm_phase(const P& p, const GArgs& g, char* smem) {
  const int j = (int)gridDim.x - 1 - (int)blockIdx.x;
  const bool chain = (EPI == EPI_GU) && g.next != nullptr;
  if (chain) {
    const int jp = j - g.ntn - g.next->ntn;
    if (jp >= 0 && jp < g.prev->ntn) {
      if (g.prev_in) gemm_tile8<EPI_RES_IN>(p, *g.prev, smem, jp);
      else gemm_tile8<EPI_RES>(p, *g.prev, smem, jp);
      handoff_publish(g.cnt);
    }
    if (j < g.ntn) {
      handoff_wait(g.cnt, (unsigned)g.prev->ntn);
      gemm_tile8<EPI>(p, g, smem, j);
      handoff_publish(g.cnt + 16);
    }
  }
  {
    pg8::Gemm gm{g.A, g.B, MP, g.ntn * 128, g.K};
    pg8::StaticOrder S;
    S.init(MP, g.ntn * 128, (int)gridDim.x, (int)blockIdx.x);
    PG8_LAS float* rsl = (PG8_LAS float*)((PG8_LAS unsigned char*)smem + 131072);
    if (EPI == EPI_INA || EPI == EPI_GU || EPI == EPI_INC) {
      const int t = tidx_();
      pg8::Unit u0;
      for (int i = (t >> 8); S.next(i, u0); i += 2) rsl[i * 256 + (t & 255)] = rstd16(g.ss, u0.pm * 256 + (t & 255));
      __syncthreads();
    }
    Epi8<EPI> E{g, &p, rsl};
    pg8::gemm_phase(( PG8_LAS unsigned char*)smem, gm, S, E);
  }
  if (chain) {
    if (j >= g.ntn && j < g.ntn + g.next->ntn) {
      handoff_wait(g.cnt + 16, (unsigned)g.ntn);
      gemm_tile8<EPI_RES>(p, *g.next, smem, j - g.ntn);
    }
  } else if (!g.skip_sample) {
    if (j < g.ntn) gemm_tile8<EPI>(p, g, smem, j);
  }
}

__device__ void phase0(const P& p, char* smem) {
  smem += VHALF * 65536;
  const int tid = VT, lane = tid & 63;
  float* tile = (float*)smem;
  constexpr int NW = 3008, NX = 2064, NR = 513;
  for (int item = VBLK; item < NW + NX + NR; item += VGRD) {
    if (item < NW) {
      int it = item;
      const float* src; const float* gain = nullptr; int K = 1024, N = 1024, mode = 0; size_t dsto;
      if (it < 384) { src = p.w_in_a; N = 3072; gain = p.norm1; dsto = W_INA; }
      else if ((it -= 384) < 128) { src = p.w_out_a; dsto = W_OUTA; }
      else if ((it -= 128) < 352) { src = p.ffn_wg; N = 2816; gain = p.norm2; dsto = W_GU0; mode = 1; }
      else if ((it -= 352) < 352) { src = p.ffn_wu; N = 2816; gain = p.norm2; dsto = W_GU0; mode = 2; }
      else if ((it -= 352) < 352) { src = p.ffn_wd; K = 2816; dsto = W_D0; }
      else if ((it -= 352) < 256) { src = p.w_in_c; N = 2048; gain = p.norm1 + 1024; dsto = W_INC; }
      else if ((it -= 256) < 128) { src = p.w_out_c; dsto = W_OUTC; }
      else if ((it -= 128) < 352) { src = p.ffn_wg + (size_t)1024 * 2816; N = 2816; gain = p.norm2 + 1024; dsto = W_GU1; mode = 1; }
      else if ((it -= 352) < 352) { src = p.ffn_wu + (size_t)1024 * 2816; N = 2816; gain = p.norm2 + 1024; dsto = W_GU1; mode = 2; }
      else { it -= 352; src = p.ffn_wd + (size_t)2816 * 1024; K = 2816; dsto = W_D1; }
      u16* dst = (u16*)(p.ws + dsto);
      const int ntn = N >> 7;
      const int kt = it / ntn, nt = it - kt * ntn, k0 = kt * 64, n0 = nt * 128;
      {
        const int nn = tid & 127, kh = tid >> 7;
        float v[32];
#pragma unroll
        for (int i = 0; i < 32; ++i) v[i] = src[(size_t)(k0 + kh + 2 * i) * N + n0 + nn];
        if (gain) {
#pragma unroll
          for (int i = 0; i < 32; ++i) v[i] *= gain[k0 + kh + 2 * i];
        }
#pragma unroll
        for (int i = 0; i < 32; ++i) tile[(kh + 2 * i) * 129 + nn] = v[i];
      }
      __syncthreads();
      {
        const int nn = tid >> 1, kc = (tid & 1) * 32;
        unsigned wv[16];
#pragma unroll
        for (int j = 0; j < 16; ++j) wv[j] = pk(tile[(kc + 2 * j) * 129 + nn], tile[(kc + 2 * j + 1) * 129 + nn]);
        const int n = n0 + nn;
        const int drow = mode == 0 ? n : ((n >> 7) * 256 + (n & 127) + (mode == 2 ? 128 : 0));
        uint4* d = (uint4*)(dst + (size_t)drow * K + k0 + kc);
        d[0] = make_uint4(wv[0], wv[1], wv[2], wv[3]);
        d[1] = make_uint4(wv[4], wv[5], wv[6], wv[7]);
        d[2] = make_uint4(wv[8], wv[9], wv[10], wv[11]);
        d[3] = make_uint4(wv[12], wv[13], wv[14], wv[15]);
      }
      __syncthreads();
    } else if (item < NW + NX) {
      const int row0 = (item - NW) * 8 + (tid >> 6) * 2;
      float4 v[2][4];
#pragma unroll
      for (int rr = 0; rr < 2; ++rr) {
        const int row = row0 + rr;
        const float* src = row < MP ? p.x_prompt + (size_t)row * D : p.x_sample + (size_t)(row - MP) * D;
#pragma unroll
        for (int i = 0; i < 4; ++i) v[rr][i] = ((const float4*)src)[lane + 64 * i];
      }
#pragma unroll
      for (int rr = 0; rr < 2; ++rr) {
        const int row = row0 + rr;
        u16* xb = (u16*)(p.ws + XB) + (size_t)row * D;
        float ss = 0.f;
#pragma unroll
        for (int i = 0; i < 4; ++i) {
          const float4 q = v[rr][i];
          ss += q.x * q.x + q.y * q.y + q.z * q.z + q.w * q.w;
          ((uint2*)xb)[lane + 64 * i] = make_uint2(pk(q.x, q.y), pk(q.z, q.w));
        }
        ss = wave_sum(ss);
        if (lane < 16) ((float*)(p.ws + SS0))[(size_t)row * 16 + lane] = lane == 0 ? ss : 0.f;
      }
    } else {
      int idx = (item - NW - NX) * 256 + tid;
      if (idx < 2049 * 64) {
        int pi = idx >> 6, i = idx & 63;
        float pos = pi < 2048 ? (float)pi : 16384.f;
        float inv = powf(10000.f, -(float)i / 64.f);
        float ang = pos * inv;
        double a = (double)ang;
        double kq = rint(a * 0.15915494309189535);
        double rr = a - kq * 6.283185307179586;
        float rf = (float)rr;
        ((float*)(p.ws + ROPEC))[idx] = cosf(rf);
        ((float*)(p.ws + ROPES))[idx] = sinf(rf);
      }
    }
  }
}

template <class F>
DEV void load_T(int tid, char* sT, const u16* src, size_t ld, F xf) {
  const int jp = tid & 63, cgp = tid >> 6;
  const u16* s0 = src + (size_t)(2 * jp) * ld + cgp * 32;
  const u16* s1 = s0 + ld;
  const int cb = ((jp >> 2)), bo = (jp & 3) * 4;
#pragma unroll
  for (int h = 0; h < 4; ++h) {
    uint4 a = *(const uint4*)(s0 + h * 8), b = *(const uint4*)(s1 + h * 8);
    float fa[8], fb[8];
    unpack8(a, fa); unpack8(b, fb);
#pragma unroll
    for (int e = 0; e < 8; ++e) {
      int c = cgp * 32 + h * 8 + e;
      *(unsigned*)(sT + toff16(c, cb) + bo) = pk(xf(0, c, fa[e]), xf(1, c, fb[e]));
    }
  }
}
DEV void load_T_ln(int tid, char* sT, const u16* src, size_t ld, float m0, float rs0, float m1, float rs1, const float* vg, const float* vb) {
  const int jp = tid & 63, cgp = tid >> 6;
  const u16* s0 = src + (size_t)(2 * jp) * ld + cgp * 32;
  const u16* s1 = s0 + ld;
  const int cb = ((jp >> 2)), bo = (jp & 3) * 4;
#pragma unroll
  for (int h = 0; h < 4; ++h) {
    uint4 a = *(const uint4*)(s0 + h * 8), b = *(const uint4*)(s1 + h * 8);
    const float4 g0 = *(const float4*)(vg + cgp * 32 + h * 8), g1 = *(const float4*)(vg + cgp * 32 + h * 8 + 4);
    const float4 b0 = *(const float4*)(vb + cgp * 32 + h * 8), b1 = *(const float4*)(vb + cgp * 32 + h * 8 + 4);
    const float gv[8] = {g0.x, g0.y, g0.z, g0.w, g1.x, g1.y, g1.z, g1.w};
    const float bv[8] = {b0.x, b0.y, b0.z, b0.w, b1.x, b1.y, b1.z, b1.w};
    float fa[8], fb[8];
    unpack8(a, fa); unpack8(b, fb);
#pragma unroll
    for (int e = 0; e < 8; ++e) {
      const int c = cgp * 32 + h * 8 + e;
      const float ga = gv[e] * rs0, gb2 = gv[e] * rs1;
      *(unsigned*)(sT + toff16(c, cb) + bo) = pk((fa[e] - m0) * ga + bv[e], (fb[e] - m1) * gb2 + bv[e]);
    }
  }
}
DEV void load_rot(int tid, char* sT, const u16* src, size_t ld, const float* cs, const float* sn, float scale) {
  const int i = tid >> 1, half = tid & 1;
  const u16* s = src + (size_t)i * ld + half * 32;
  const float* c_ = cs + (size_t)i * 64 + half * 32;
  const float* s_ = sn + (size_t)i * 64 + half * 32;
#pragma unroll
  for (int h = 0; h < 4; ++h) {
    uint4 lo = *(const uint4*)(s + h * 8), hi = *(const uint4*)(s + 64 + h * 8);
    float fl[8], fh[8], ol[8], oh[8];
    unpack8(lo, fl); unpack8(hi, fh);
    float4 c0 = *(const float4*)(c_ + h * 8), c1 = *(const float4*)(c_ + h * 8 + 4);
    float4 s0 = *(const float4*)(s_ + h * 8), s1 = *(const float4*)(s_ + h * 8 + 4);
    float cc[8] = {c0.x, c0.y, c0.z, c0.w, c1.x, c1.y, c1.z, c1.w};
    float sv[8] = {s0.x, s0.y, s0.z, s0.w, s1.x, s1.y, s1.z, s1.w};
#pragma unroll
    for (int e = 0; e < 8; ++e) {
      ol[e] = (fl[e] * cc[e] - fh[e] * sv[e]) * scale;
      oh[e] = (fh[e] * cc[e] + fl[e] * sv[e]) * scale;
    }
    *(uint4*)(sT + toff16(i, half * 4 + h)) = pack8(ol);
    *(uint4*)(sT + toff16(i, 8 + half * 4 + h)) = pack8(oh);
  }
}
DEV void load_rot_T(int tid, char* sT, const u16* src, size_t ld, const float* cs, const float* sn) {
  const int jp = tid & 63, w = tid >> 6;
  const u16* s0 = src + (size_t)(2 * jp) * ld + w * 16;
  const u16* s1 = s0 + ld;
  const float* c0p = cs + (size_t)(2 * jp) * 64 + w * 16;
  const float* s0p = sn + (size_t)(2 * jp) * 64 + w * 16;
  const int cb = jp >> 2, bo = (jp & 3) * 4;
#pragma unroll
  for (int h = 0; h < 2; ++h) {
    float fl0[8], fh0[8], fl1[8], fh1[8];
    unpack8(*(const uint4*)(s0 + h * 8), fl0); unpack8(*(const uint4*)(s0 + 64 + h * 8), fh0);
    unpack8(*(const uint4*)(s1 + h * 8), fl1); unpack8(*(const uint4*)(s1 + 64 + h * 8), fh1);
#pragma unroll
    for (int e4 = 0; e4 < 2; ++e4) {
      float4 ca = *(const float4*)(c0p + h * 8 + e4 * 4), sa = *(const float4*)(s0p + h * 8 + e4 * 4);
      float4 cb4 = *(const float4*)(c0p + 64 + h * 8 + e4 * 4), sb4 = *(const float4*)(s0p + 64 + h * 8 + e4 * 4);
      float c0a[4] = {ca.x, ca.y, ca.z, ca.w}, s0a[4] = {sa.x, sa.y, sa.z, sa.w};
      float c1a[4] = {cb4.x, cb4.y, cb4.z, cb4.w}, s1a[4] = {sb4.x, sb4.y, sb4.z, sb4.w};
#pragma unroll
      for (int e = 0; e < 4; ++e) {
        int ee = e4 * 4 + e;
        int d = w * 16 + h * 8 + ee;
        float l0 = fl0[ee] * c0a[e] - fh0[ee] * s0a[e], h0 = fh0[ee] * c0a[e] + fl0[ee] * s0a[e];
        float l1 = fl1[ee] * c1a[e] - fh1[ee] * s1a[e], h1 = fh1[ee] * c1a[e] + fl1[ee] * s1a[e];
        *(unsigned*)(sT + toff16(d, cb) + bo) = pk(l0, l1);
        *(unsigned*)(sT + toff16(d + 64, cb) + bo) = pk(h0, h1);
      }
    }
  }
}
DEV void load_N(int tid, char* sT, const u16* src, size_t ld) {
#pragma unroll
  for (int i = 0; i < 8; ++i) {
    int idx = tid + 256 * i, row = idx >> 4, ch = idx & 15;
    *(uint4*)(sT + toff16(row, ch)) = *(const uint4*)(src + (size_t)row * ld + ch * 8);
  }
}

struct RotTab { float4 c[8], s[8]; };
struct RotDat { uint4 lo[4], hi[4]; };
DEV void rot_tab_issue(RotTab& T, int tid, const float* cs, const float* sn) {
  const int i = tid >> 1, half = tid & 1;
  const float* c_ = cs + (size_t)i * 64 + half * 32;
  const float* s_ = sn + (size_t)i * 64 + half * 32;
#pragma unroll
  for (int h = 0; h < 4; ++h) {
    T.c[2 * h] = *(const float4*)(c_ + h * 8); T.c[2 * h + 1] = *(const float4*)(c_ + h * 8 + 4);
    T.s[2 * h] = *(const float4*)(s_ + h * 8); T.s[2 * h + 1] = *(const float4*)(s_ + h * 8 + 4);
  }
}
DEV void rot_dat_issue(RotDat& R, int tid, const u16* src, size_t ld) {
  const int i = tid >> 1, half = tid & 1;
  const u16* s = src + (size_t)i * ld + half * 32;
#pragma unroll
  for (int h = 0; h < 4; ++h) { R.lo[h] = *(const uint4*)(s + h * 8); R.hi[h] = *(const uint4*)(s + 64 + h * 8); }
}
DEV void rot_commit(const RotDat& R, const RotTab& T, int tid, char* sT, float scale) {
  const int i = tid >> 1, half = tid & 1;
#pragma unroll
  for (int h = 0; h < 4; ++h) {
    float fl[8], fh[8], ol[8], oh[8];
    unpack8(R.lo[h], fl); unpack8(R.hi[h], fh);
    const float4 c0 = T.c[2 * h], c1 = T.c[2 * h + 1], s0 = T.s[2 * h], s1 = T.s[2 * h + 1];
    const float cc[8] = {c0.x, c0.y, c0.z, c0.w, c1.x, c1.y, c1.z, c1.w};
    const float sv[8] = {s0.x, s0.y, s0.z, s0.w, s1.x, s1.y, s1.z, s1.w};
#pragma unroll
    for (int e = 0; e < 8; ++e) {
      ol[e] = (fl[e] * cc[e] - fh[e] * sv[e]) * scale;
      oh[e] = (fh[e] * cc[e] + fl[e] * sv[e]) * scale;
    }
    *(uint4*)(sT + toff16(i, half * 4 + h)) = pack8(ol);
    *(uint4*)(sT + toff16(i, 8 + half * 4 + h)) = pack8(oh);
  }
}
struct TDat { uint4 a[4], b[4]; };
DEV void T_issue(TDat& R, int tid, const u16* src, size_t ld) {
  const int jp = tid & 63, cgp = tid >> 6;
  const u16* s0 = src + (size_t)(2 * jp) * ld + cgp * 32;
  const u16* s1 = s0 + ld;
#pragma unroll
  for (int h = 0; h < 4; ++h) { R.a[h] = *(const uint4*)(s0 + h * 8); R.b[h] = *(const uint4*)(s1 + h * 8); }
}
DEV void T_commit(const TDat& R, int tid, char* sT) {
  const int jp = tid & 63, cgp = tid >> 6;
  const int cb = jp >> 2, bo = (jp & 3) * 4;
#pragma unroll
  for (int h = 0; h < 4; ++h) {
    float fa[8], fb[8];
    unpack8(R.a[h], fa); unpack8(R.b[h], fb);
#pragma unroll
    for (int e = 0; e < 8; ++e) {
      const int c = cgp * 32 + h * 8 + e;
      *(unsigned*)(sT + toff16(c, cb) + bo) = pk(fa[e], fb[e]);
    }
  }
}

__device__ void phase2(const P& p, char* smem) {
  smem += VHALF * 65536;
  const u16* Z = (const u16*)(p.ws + ZB);
  u16* YB = (u16*)(p.ws + YBO);
  const float* cosT = (const float*)(p.ws + ROPEC);
  const float* sinT = (const float*)(p.ws + ROPES);
  float* out = p.out;
  for (int item = VBLK; item < 2048; item += VGRD) {
    int tid = VT;
    asm volatile("" : "+v"(tid));
    const int lane = tid & 63, w = tid >> 6, wm = w >> 1, wn = w & 1, r = lane & 15, q = lane >> 4;
    if (item < 512) {
      const int b = item >> 6, h = (item >> 4) & 3, c = item & 15;
      const size_t R0 = (size_t)b * 2048 + c * 128;
      const float lg = lgh(h);
      char* sV = smem; char* sK = smem + 32768;
      {
        const int jp = tid & 63;
        const float z0 = expf((127.f - 2.f * jp) * lg), z1 = expf((126.f - 2.f * jp) * lg);
        load_T(tid, sV, Z + R0 * 3072 + 1024 + h * 128, 3072, [=](int which, int, float v) { return v * (which ? z1 : z0); });
      }
      load_rot_T(tid, sK, Z + R0 * 3072 + 512 + h * 128, 3072, cosT + (size_t)c * 128 * 64, sinT + (size_t)c * 128 * 64);
      __syncthreads();
      f32x4 acc[4][4];
      zero_acc(acc);
      mma_tile<16>(acc, sV, sK, wm, wn, lane);
      u16* uc = (u16*)(p.ws + UCO) + (size_t)item * 16384;
#pragma unroll
      for (int mi = 0; mi < 4; ++mi)
#pragma unroll
        for (int ni = 0; ni < 4; ++ni) {
          int e = wm * 64 + mi * 16 + r, d = wn * 64 + ni * 16 + q * 4;
          *(uint2*)(uc + e * 128 + d) = make_uint2(pk(acc[mi][ni][0], acc[mi][ni][1]), pk(acc[mi][ni][2], acc[mi][ni][3]));
        }
      __syncthreads();
    } else if (item < 1536) {
      const int it = item - 512, b = it >> 7, c = (it >> 3) & 15, n = it & 7;
      const size_t R0 = (size_t)b * 2048 + c * 128;
      char* sX = smem;
      char* sA = smem + 32768; char* sB = smem + 49152;
      char* sBv = smem + 32768;
      {
        const int t = tid >> 1, half = tid & 1, ch0 = n * 64 + half * 32;
        float xc[32];
#pragma unroll
        for (int k = 0; k < 8; ++k) {
          float4 v = *(const float4*)(p.conv_b + ch0 + k * 4);
          xc[k * 4] = v.x; xc[k * 4 + 1] = v.y; xc[k * 4 + 2] = v.z; xc[k * 4 + 3] = v.w;
        }
#pragma unroll
        for (int j = 0; j < 4; ++j) {
          int tt = c * 128 + t - 3 + j;
          if (tt >= 0) {
            const u16* s = Z + ((size_t)b * 2048 + tt) * 3072 + 2048 + ch0;
            const float* cw = p.conv_w + j * 512 + ch0;
#pragma unroll
            for (int hh = 0; hh < 4; ++hh) {
              float x[8];
              unpack8(*(const uint4*)(s + hh * 8), x);
              float4 w0 = *(const float4*)(cw + hh * 8), w1 = *(const float4*)(cw + hh * 8 + 4);
              xc[hh * 8 + 0] += w0.x * x[0]; xc[hh * 8 + 1] += w0.y * x[1]; xc[hh * 8 + 2] += w0.z * x[2]; xc[hh * 8 + 3] += w0.w * x[3];
              xc[hh * 8 + 4] += w1.x * x[4]; xc[hh * 8 + 5] += w1.y * x[5]; xc[hh * 8 + 6] += w1.z * x[6]; xc[hh * 8 + 7] += w1.w * x[7];
            }
          }
        }
#pragma unroll
        for (int k = 0; k < 8; ++k)
          *(float4*)(sX + xoff(t, half * 32 + k * 4)) = make_float4(xc[k * 4], xc[k * 4 + 1], xc[k * 4 + 2], xc[k * 4 + 3]);
#pragma unroll
        for (int hh = 0; hh < 4; ++hh) *(uint4*)(sA + toff8(t, half * 4 + hh)) = pack8(xc + hh * 8);
      }
      {
        const int d = tid & 63, cgp = tid >> 6;
        const float* wa = p.lru_wa + (size_t)n * 4096 + d;
        const float* wx = p.lru_wx + (size_t)n * 4096 + d;
        float fa[16], fx[16];
#pragma unroll
        for (int k = 0; k < 16; ++k) { fa[k] = wa[(cgp * 16 + k) * 64]; fx[k] = wx[(cgp * 16 + k) * 64]; }
        const int rowA = (d >> 5) * 64 + ((d >> 4) & 1) * 32 + (d & 15), rowX = rowA + 16;
        *(uint4*)(sB + toff8(rowA, cgp * 2)) = pack8(fa);
        *(uint4*)(sB + toff8(rowA, cgp * 2 + 1)) = pack8(fa + 8);
        *(uint4*)(sB + toff8(rowX, cgp * 2)) = pack8(fx);
        *(uint4*)(sB + toff8(rowX, cgp * 2 + 1)) = pack8(fx + 8);
      }
      float bav2[2][4], bxv2[2][4], lav2[2][4];
#pragma unroll
      for (int pp = 0; pp < 2; ++pp) {
        const int chg = n * 64 + wn * 32 + pp * 16 + q * 4;
        const float4 ba = *(const float4*)(p.lru_ba + chg), bx = *(const float4*)(p.lru_bx + chg), lam = *(const float4*)(p.lru_lambda + chg);
        bav2[pp][0] = ba.x; bav2[pp][1] = ba.y; bav2[pp][2] = ba.z; bav2[pp][3] = ba.w;
        bxv2[pp][0] = bx.x; bxv2[pp][1] = bx.y; bxv2[pp][2] = bx.z; bxv2[pp][3] = bx.w;
        lav2[pp][0] = -8.f * log1pf(__expf(-lam.x)); lav2[pp][1] = -8.f * log1pf(__expf(-lam.y));
        lav2[pp][2] = -8.f * log1pf(__expf(-lam.z)); lav2[pp][3] = -8.f * log1pf(__expf(-lam.w));
      }
      __syncthreads();
      f32x4 acc[4][4];
      zero_acc(acc);
      mma_tile<8>(acc, sA, sB, wm, wn, lane);
#pragma unroll
      for (int mi = 0; mi < 4; ++mi)
#pragma unroll
        for (int pp = 0; pp < 2; ++pp) {
          const int t = wm * 64 + mi * 16 + r, chl = wn * 32 + pp * 16 + q * 4;
          float4 xv = *(const float4*)(sX + xoff(t, chl));
          const float* bav = bav2[pp]; const float* bxv = bxv2[pp]; const float* lav = lav2[pp];
          float xvv[4] = {xv.x, xv.y, xv.z, xv.w};
#pragma unroll
          for (int j = 0; j < 4; ++j) {
            float rr = sigmoidf_(acc[mi][2 * pp][j] + bav[j]);
            float ii = sigmoidf_(acc[mi][2 * pp + 1][j] + bxv[j]);
            float la = rr * lav[j];
            float a = __expf(la);
            float mult = sqrtf(fmaxf(1.f - a * a, 0.f));
            acc[mi][2 * pp][j] = a;
            acc[mi][2 * pp + 1][j] = xvv[j] * ii * mult;
          }
        }
      __syncthreads();
#pragma unroll
      for (int mi = 0; mi < 4; ++mi)
#pragma unroll
        for (int pp = 0; pp < 2; ++pp) {
          const int t = wm * 64 + mi * 16 + r, chl = wn * 32 + pp * 16 + q * 4;
          *(f32x4*)(sX + xoff(t, chl)) = acc[mi][2 * pp];
          *(f32x4*)(sBv + xoff(t, chl)) = acc[mi][2 * pp + 1];
        }
      __syncthreads();
      {
        const int ch = lane, t0 = w * 32;
        float hl_[32], pl_[32];
        float hh = 0.f, pq = 1.f;
#pragma unroll
        for (int t = 0; t < 32; ++t) {
          const float a = *(const float*)(sX + xoff(t0 + t, ch)), bb = *(const float*)(sBv + xoff(t0 + t, ch));
          hh = a * hh + bb;
          pq *= a;
          hl_[t] = hh; pl_[t] = pq;
        }
        __syncthreads();
        float* carry = (float*)sX;
        carry[(w * 2 + 0) * 64 + ch] = pq;
        carry[(w * 2 + 1) * 64 + ch] = hh;
        __syncthreads();
        float hin = 0.f, pin = 1.f;
#pragma unroll
        for (int ww = 0; ww < 3; ++ww) {
          if (ww < w) {
            const float pw = carry[(ww * 2 + 0) * 64 + ch], hw = carry[(ww * 2 + 1) * 64 + ch];
            hin = pw * hin + hw;
            pin *= pw;
          }
        }
        u16* hl = (u16*)out + (R0 + t0) * 512 + n * 64 + ch;
        u16* pl = (u16*)out + 8388608 + (R0 + t0) * 512 + n * 64 + ch;
#pragma unroll
        for (int t = 0; t < 32; ++t) {
          hl[(size_t)t * 512] = f2bf(hl_[t] + pl_[t] * hin);
          pl[(size_t)t * 512] = f2bf(pl_[t] * pin);
        }
        if (w == 3) {
          ((float*)(p.ws + AGGP))[(b * 16 + c) * 512 + n * 64 + ch] = pl_[31] * pin;
          ((float*)(p.ws + AGGH))[(b * 16 + c) * 512 + n * 64 + ch] = hl_[31] + pl_[31] * hin;
        }
      }
      __syncthreads();
    } else {
      const int it = item - 1536, b = it >> 2, h = it & 3;
      const size_t row = MP + b;
      float* sq = (float*)smem; float* sk = sq + 128; float* sv = sq + 256; float* red = sq + 384;
      float4 s0v[16];
      {
        const float* S0p = p.state_ret + ((size_t)(b * 4 + h) * 128) * 128 + (tid >> 5) * 16 * 128 + (tid & 31) * 4;
#pragma unroll
        for (int dd = 0; dd < 16; ++dd) s0v[dd] = *(const float4*)(S0p + dd * 128);
      }
      if (tid < 128) {
        const int d = tid, dl = d & 63;
        const float cc = cosT[2048 * 64 + dl], sn = sinT[2048 * 64 + dl];
        const u16* zr = Z + row * 3072 + h * 128;
        float q1 = bf(zr[dl]), q2 = bf(zr[dl + 64]), k1 = bf(zr[512 + dl]), k2 = bf(zr[512 + dl + 64]);
        float qo = d < 64 ? q1 * cc - q2 * sn : q2 * cc + q1 * sn;
        float ko = d < 64 ? k1 * cc - k2 * sn : k2 * cc + k1 * sn;
        sq[d] = qo * 0.08838834764831845f; sk[d] = ko; sv[d] = bf(zr[1024 + d]);
      }
      __syncthreads();
      {
        const float gamma = 1.f - exp2f(-5.f - (float)h);
        const int e4 = tid & 31, dg = tid >> 5;
        const size_t so = ((size_t)(b * 4 + h) * 128) * 128;
        const float* S0 = p.state_ret + so;
        float* Sn = out + O_RETS + so;
        const float4 v4 = *(const float4*)(sv + e4 * 4);
        float4 o = make_float4(0.f, 0.f, 0.f, 0.f);
#pragma unroll
        for (int dd = 0; dd < 16; ++dd) {
          const int d = dg * 16 + dd;
          const float4 s0 = s0v[dd];
          const float kd = sk[d], qd = sq[d];
          float4 s1;
          s1.x = gamma * s0.x + kd * v4.x; s1.y = gamma * s0.y + kd * v4.y; s1.z = gamma * s0.z + kd * v4.z; s1.w = gamma * s0.w + kd * v4.w;
          *(float4*)(Sn + d * 128 + e4 * 4) = s1;
          o.x += qd * s1.x; o.y += qd * s1.y; o.z += qd * s1.z; o.w += qd * s1.w;
        }
        *(float4*)(red + dg * 128 + e4 * 4) = o;
      }
      __syncthreads();
      if (tid < 64) {
        float o1 = 0.f, o2 = 0.f;
#pragma unroll
        for (int dg = 0; dg < 8; ++dg) { o1 += red[dg * 128 + tid]; o2 += red[dg * 128 + 64 + tid]; }
        const float mean = wave_sum(o1 + o2) * (1.f / 128.f);
        const float d1 = o1 - mean, d2 = o2 - mean;
        const float var = wave_sum(d1 * d1 + d2 * d2) * (1.f / 128.f);
        const float rs = rsqrtf(var + EPS);
        const u16* zg = Z + row * 3072 + 1536 + h * 128;
        const float g1 = bf(zg[tid]), g2 = bf(zg[tid + 64]);
        YB[row * 1024 + h * 128 + tid] = f2bf(d1 * rs * p.ret_gn[h * 128 + tid] * siluf_(g1));
        YB[row * 1024 + h * 128 + 64 + tid] = f2bf(d2 * rs * p.ret_gn[h * 128 + 64 + tid] * siluf_(g2));
      }
      __syncthreads();
      if (h < 2) {
        float* xs = (float*)(smem + 8192);
        const int ch = h * 256 + tid;
        {
          const float x = bf(Z[row * 3072 + 2048 + ch]);
          const float b0 = p.state_conv[(b * 3 + 0) * 512 + ch], b1 = p.state_conv[(b * 3 + 1) * 512 + ch], b2 = p.state_conv[(b * 3 + 2) * 512 + ch];
          xs[tid] = p.conv_b[ch] + p.conv_w[ch] * b0 + p.conv_w[512 + ch] * b1 + p.conv_w[1024 + ch] * b2 + p.conv_w[1536 + ch] * x;
          out[O_CONVS + (b * 3 + 0) * 512 + ch] = b1;
          out[O_CONVS + (b * 3 + 1) * 512 + ch] = b2;
          out[O_CONVS + (b * 3 + 2) * 512 + ch] = x;
        }
        __syncthreads();
        {
          const int n = ch >> 6, d = ch & 63;
          float racc = p.lru_ba[ch], iacc = p.lru_bx[ch];
          const float* wa = p.lru_wa + (size_t)n * 4096 + d;
          const float* wx = p.lru_wx + (size_t)n * 4096 + d;
#pragma unroll 16
          for (int cc = 0; cc < 64; ++cc) {
            const float xv = xs[(n & 3) * 64 + cc];
            racc += xv * wa[cc * 64];
            iacc += xv * wx[cc * 64];
          }
          const float rr = sigmoidf_(racc), ii = sigmoidf_(iacc);
          const float la = -8.f * rr * log1pf(expf(-p.lru_lambda[ch]));
          const float a = expf(la), mult = sqrtf(-expm1f(2.f * la));
          const float hv = a * p.state_lru[b * 512 + ch] + mult * ii * xs[tid];
          out[O_LRUS + b * 512 + ch] = hv;
          const float gb = bf(Z[row * 3072 + 2560 + ch]);
          YB[row * 1024 + 512 + ch] = f2bf(hv * geluf_(gb));
        }
        __syncthreads();
      }
    }
  }
  for (int idx = blockIdx.x * blockDim.x + threadIdx.x; idx < 12288; idx += gridDim.x * blockDim.x) {
    const int b = idx / 1536, j = (idx / 512) % 3, ch = idx & 511;
    out[O_CONVP + idx] = bf(Z[((size_t)b * 2048 + 2045 + j) * 3072 + 2048 + ch]);
  }
}

__device__ void phase3(const P& p, int part = 3) {
  const int gt = blockIdx.x * blockDim.x + threadIdx.x, gn = gridDim.x * blockDim.x;
  const u16* Z = (const u16*)(p.ws + ZB);
  u16* YB = (u16*)(p.ws + YBO);
  float* out = p.out;
  if (part & 1) {
    const u16* UC = (const u16*)(p.ws + UCO);
    u16* SST = (u16*)(p.ws + SSTO);
    for (int v = gt; v < 131072; v += gn) {
      const int bh = v >> 12, idx4 = (v & 4095) * 4, e = idx4 >> 7, d = idx4 & 127;
      const float g128 = expf(128.f * lgh(bh & 3));
      float4 s = make_float4(0.f, 0.f, 0.f, 0.f);
      uint2 uu[16];
#pragma unroll
      for (int c = 0; c < 16; ++c) uu[c] = *(const uint2*)(UC + ((size_t)(bh * 16 + c)) * 16384 + idx4);
#pragma unroll
      for (int c = 0; c < 16; ++c) {
        const size_t o = ((size_t)(bh * 16 + c)) * 16384 + idx4;
        *(uint2*)(SST + o) = make_uint2(pk(s.x, s.y), pk(s.z, s.w));
        const float4 u = make_float4(blo(uu[c].x), bhi(uu[c].x), blo(uu[c].y), bhi(uu[c].y));
        s.x = g128 * s.x + u.x; s.y = g128 * s.y + u.y; s.z = g128 * s.z + u.z; s.w = g128 * s.w + u.w;
      }
      float* o = out + O_RETP + ((size_t)bh * 128 + d) * 128 + e;
      o[0] = s.x; o[128] = s.y; o[256] = s.z; o[384] = s.w;
    }
  }
  if (part & 2) {
    const float* aggP = (const float*)(p.ws + AGGP);
    const float* aggH = (const float*)(p.ws + AGGH);
    for (int v = gt; v < 131072; v += gn) {
      const int ch = (v & 127) * 4, rg = (v >> 7) & 7, c = (v >> 10) & 15, b = v >> 14;
      float4 hs = make_float4(0.f, 0.f, 0.f, 0.f);
#pragma unroll
      for (int cc = 0; cc < 15; ++cc) {
        if (cc < c) {
          float4 pp = *(const float4*)(aggP + (b * 16 + cc) * 512 + ch), hh = *(const float4*)(aggH + (b * 16 + cc) * 512 + ch);
          hs.x = pp.x * hs.x + hh.x; hs.y = pp.y * hs.y + hh.y; hs.z = pp.z * hs.z + hh.z; hs.w = pp.w * hs.w + hh.w;
        }
      }
      const int row0 = b * 2048 + c * 128 + rg * 16;
#pragma unroll 8
      for (int i = 0; i < 16; ++i) {
        const int row = row0 + i;
        const uint2 hl2 = *(const uint2*)((const u16*)out + (size_t)row * 512 + ch), pq2 = *(const uint2*)((const u16*)out + 8388608 + (size_t)row * 512 + ch);
        const float4 hl = make_float4(blo(hl2.x), bhi(hl2.x), blo(hl2.y), bhi(hl2.y)), pq = make_float4(blo(pq2.x), bhi(pq2.x), blo(pq2.y), bhi(pq2.y));
        float4 hv;
        hv.x = hl.x + pq.x * hs.x; hv.y = hl.y + pq.y * hs.y; hv.z = hl.z + pq.z * hs.z; hv.w = hl.w + pq.w * hs.w;
        uint2 g = *(const uint2*)(Z + (size_t)row * 3072 + 2560 + ch);
        *(uint2*)(YB + (size_t)row * 1024 + 512 + ch) =
            make_uint2(pk(hv.x * geluf_(blo(g.x)), hv.y * geluf_(bhi(g.x))), pk(hv.z * geluf_(blo(g.y)), hv.w * geluf_(bhi(g.y))));
        if ((row & 2047) == 2047) *(float4*)(out + O_LRUP + b * 512 + ch) = hv;
      }
    }
  }
}

__device__ void phase4(const P& p, char* smem) {
  smem += VHALF * 65536;
  const u16* Z = (const u16*)(p.ws + ZB);
  u16* YB = (u16*)(p.ws + YBO);
  const u16* SST = (const u16*)(p.ws + SSTO);
  const float* cosT = (const float*)(p.ws + ROPEC);
  const float* sinT = (const float*)(p.ws + ROPES);
  char* bufA = smem; char* bufB = smem + 32768;
  for (int item = VBLK; item < 512; item += VGRD) {
    int tid = VT;
    asm volatile("" : "+v"(tid));
    const int lane = tid & 63, w = tid >> 6, wm = w >> 1, wn = w & 1, r = lane & 15, q = lane >> 4;
    const int b = item >> 6, h = (item >> 4) & 3, c = item & 15;
    const size_t R0 = (size_t)b * 2048 + c * 128;
    const float lg = lgh(h);
    const float* cs = cosT + (size_t)c * 128 * 64;
    const float* sn = sinT + (size_t)c * 128 * 64;
    RotTab T;
    RotDat qd, kd;
    rot_tab_issue(T, tid, cs, sn);
    rot_dat_issue(qd, tid, Z + R0 * 3072 + h * 128, 3072);
    load_N(tid, bufB, SST + (size_t)item * 16384, 128);
    rot_commit(qd, T, tid, bufA, 0.08838834764831845f);
    rot_dat_issue(kd, tid, Z + R0 * 3072 + 512 + h * 128, 3072);
    __syncthreads();
    f32x4 acco[4][4];
    zero_acc(acco);
    mma_tile<16>(acco, bufA, bufB, wm, wn, lane);
#pragma unroll
    for (int mi = 0; mi < 4; ++mi) {
      const float xi = expf((float)(wm * 64 + mi * 16 + r + 1) * lg);
#pragma unroll
      for (int ni = 0; ni < 4; ++ni) acco[mi][ni] *= xi;
    }
    __syncthreads();
    rot_commit(kd, T, tid, bufB, 1.f);
    TDat vd;
    T_issue(vd, tid, Z + R0 * 3072 + 1024 + h * 128, 3072);
    __syncthreads();
    f32x4 accs[4][4];
    zero_acc(accs);
    mma_tile<16>(accs, bufA, bufB, wm, wn, lane);
    __syncthreads();
#pragma unroll
    for (int mi = 0; mi < 4; ++mi)
#pragma unroll
      for (int ni = 0; ni < 4; ++ni) {
        const int i = wm * 64 + mi * 16 + r, j0 = wn * 64 + ni * 16 + q * 4;
        float o[4];
#pragma unroll
        for (int j = 0; j < 4; ++j) {
          const int df = i - (j0 + j);
          o[j] = df >= 0 ? accs[mi][ni][j] * __expf((float)df * lg) : 0.f;
        }
        *(uint2*)(bufA + toff16(i, j0 >> 3) + (j0 & 7) * 2) = make_uint2(pk(o[0], o[1]), pk(o[2], o[3]));
      }
    T_commit(vd, tid, bufB);
    const int gi = tid >> 1, ghalf = tid & 1;
    const u16* zg = Z + (R0 + gi) * 3072 + 1536 + h * 128 + ghalf * 64;
    const float* gn = p.ret_gn + h * 128 + ghalf * 64;
    uint4 gq[8];
    float4 gn0[8], gn1[8];
#pragma unroll
    for (int k = 0; k < 8; ++k) { gq[k] = *(const uint4*)(zg + k * 8); gn0[k] = *(const float4*)(gn + k * 8); gn1[k] = *(const float4*)(gn + k * 8 + 4); }
    __syncthreads();
    mma_tile<16>(acco, bufA, bufB, wm, wn, lane);
    __syncthreads();
#pragma unroll
    for (int mi = 0; mi < 4; ++mi)
#pragma unroll
      for (int ni = 0; ni < 4; ++ni) {
        const int i = wm * 64 + mi * 16 + r, e = wn * 64 + ni * 16 + q * 4;
        *(f32x4*)(smem + ooff(i, e)) = acco[mi][ni];
      }
    __syncthreads();
    {
      const int i = gi, half = ghalf;
      float x[64];
      float s = 0.f;
#pragma unroll
      for (int k = 0; k < 16; ++k) {
        float4 v = *(const float4*)(smem + ooff(i, half * 64 + k * 4));
        x[k * 4] = v.x; x[k * 4 + 1] = v.y; x[k * 4 + 2] = v.z; x[k * 4 + 3] = v.w;
        s += v.x + v.y + v.z + v.w;
      }
      s += __shfl_xor(s, 1);
      const float mean = s * (1.f / 128.f);
      float vs = 0.f;
#pragma unroll
      for (int k = 0; k < 64; ++k) { x[k] -= mean; vs += x[k] * x[k]; }
      vs += __shfl_xor(vs, 1);
      const float rs = rsqrtf(vs * (1.f / 128.f) + EPS);
      u16* yo = YB + (R0 + i) * 1024 + h * 128 + half * 64;
#pragma unroll
      for (int k = 0; k < 8; ++k) {
        float g[8], o[8];
        unpack8(gq[k], g);
        const float4 g0 = gn0[k], g1 = gn1[k];
        float gv[8] = {g0.x, g0.y, g0.z, g0.w, g1.x, g1.y, g1.z, g1.w};
#pragma unroll
        for (int e = 0; e < 8; ++e) o[e] = x[k * 8 + e] * rs * gv[e] * siluf_(g[e]);
        *(uint4*)(yo + k * 8) = pack8(o);
      }
    }
    __syncthreads();
  }
}

__device__ void phase9(const P& p, char* smem) {
  smem += VHALF * 65536;
  const u16* UB = (const u16*)(p.ws + ZB);
  const u16* VB = (const u16*)(p.ws + ZB + 33816576);
  u16* YB = (u16*)(p.ws + YBO);
  const float* lns = (const float*)(p.ws + LNSO);
  const float* lnq = (const float*)(p.ws + LNQO);
  char* bufA = smem; char* bufB = smem + 32768;
  for (int item = VBLK; item < 1024 + 32; item += VGRD) {
    int tid = VT;
    asm volatile("" : "+v"(tid));
    const int lane = tid & 63, w = tid >> 6, wm = w >> 1, wn = w & 1, r = lane & 15, q = lane >> 4;
    if (item < 1024) {
      const int b = item >> 7, c = (item >> 3) & 15, g = item & 7;
      const size_t R0 = (size_t)b * 2048 + c * 128;
#pragma unroll
      for (int i = 0; i < 8; ++i) {
        int idx = tid + 256 * i, row = idx >> 4, ch = idx & 15;
        const float* s = p.sg_ws + ((size_t)(g * 128 + row)) * 128 + ch * 8;
        float4 a = *(const float4*)s, bq = *(const float4*)(s + 4);
        float f[8] = {a.x, a.y, a.z, a.w, bq.x, bq.y, bq.z, bq.w};
#pragma unroll
        for (int e = 0; e < 8; ++e) f[e] = (ch * 8 + e <= row) ? f[e] : 0.f;
        *(uint4*)(bufA + toff16(row, ch)) = pack8(f);
      }
      {
        const int jp = tid & 63;
        const int r0 = (int)R0 + 2 * jp;
        const float m0 = sum16(lns, r0) * (1.f / 1024.f), m1 = sum16(lns, r0 + 1) * (1.f / 1024.f);
        const float v0 = sum16(lnq, r0) * (1.f / 1024.f) - m0 * m0, v1 = sum16(lnq, r0 + 1) * (1.f / 1024.f) - m1 * m1;
        const float rs0 = rsqrtf(fmaxf(v0, 0.f) + EPS), rs1 = rsqrtf(fmaxf(v1, 0.f) + EPS);
        const float* vg = p.sg_norm_g + g * 128; const float* vb = p.sg_norm_b + g * 128;
        load_T_ln(tid, bufB, VB + R0 * 1024 + g * 128, 1024, m0, rs0, m1, rs1, vg, vb);
      }
      uint2 uu[4][4];
      float bsv[4];
#pragma unroll
      for (int mi = 0; mi < 4; ++mi) {
        const int i = wm * 64 + mi * 16 + r;
        bsv[mi] = p.sg_bs[g * 128 + i];
#pragma unroll
        for (int ni = 0; ni < 4; ++ni) uu[mi][ni] = *(const uint2*)(UB + (R0 + i) * 1024 + g * 128 + wn * 64 + ni * 16 + q * 4);
      }
      __syncthreads();
      f32x4 acc[4][4];
      zero_acc(acc);
      mma_tile<16>(acc, bufA, bufB, wm, wn, lane);
#pragma unroll
      for (int mi = 0; mi < 4; ++mi) {
        const int i = wm * 64 + mi * 16 + r;
        const float bs = bsv[mi];
#pragma unroll
        for (int ni = 0; ni < 4; ++ni) {
          const size_t o = (R0 + i) * 1024 + g * 128 + wn * 64 + ni * 16 + q * 4;
          const uint2 u = uu[mi][ni];
          f32x4 a = acc[mi][ni];
          *(uint2*)(YB + o) = make_uint2(pk(blo(u.x) * (a[0] + bs), bhi(u.x) * (a[1] + bs)), pk(blo(u.y) * (a[2] + bs), bhi(u.y) * (a[3] + bs)));
        }
      }
      __syncthreads();
    } else {
      const int row = MP + (item - 1024) * 4 + w;
      const float m = sum16(lns, row) * (1.f / 1024.f);
      const float var = sum16(lnq, row) * (1.f / 1024.f) - m * m;
      const float rs = rsqrtf(fmaxf(var, 0.f) + EPS);
#pragma unroll
      for (int i = 0; i < 4; ++i) {
        const int ch = (lane + 64 * i) * 4, g = ch >> 7;
        uint2 vv = *(const uint2*)(VB + (size_t)row * 1024 + ch), uu = *(const uint2*)(UB + (size_t)row * 1024 + ch);
        float4 gg = *(const float4*)(p.sg_norm_g + ch), bb = *(const float4*)(p.sg_norm_b + ch);
        float4 vn;
        vn.x = (blo(vv.x) - m) * rs * gg.x + bb.x; vn.y = (bhi(vv.x) - m) * rs * gg.y + bb.y;
        vn.z = (blo(vv.y) - m) * rs * gg.z + bb.z; vn.w = (bhi(vv.y) - m) * rs * gg.w + bb.w;
        *(float4*)(p.out + O_SGUV + (size_t)(row - MP) * 1024 + ch) = vn;
        const float w00 = p.sg_ws[(size_t)g * 16384], b0 = p.sg_bs[g * 128];
        *(uint2*)(YB + (size_t)row * 1024 + ch) =
            make_uint2(pk(blo(uu.x) * (w00 * vn.x + b0), bhi(uu.x) * (w00 * vn.y + b0)), pk(blo(uu.y) * (w00 * vn.z + b0), bhi(uu.y) * (w00 * vn.w + b0)));
      }
    }
  }
}

__device__ void phase13(const P& p) {
  const int lane = tidx_() & 63, w = VT >> 6;
  const u16* xb = (const u16*)(p.ws + XB);
  for (int item = VBLK; item < 2064; item += VGRD) {
    const int row0 = item * 8 + w * 2;
    uint4 v[2][2];
#pragma unroll
    for (int rr = 0; rr < 2; ++rr)
#pragma unroll
      for (int i = 0; i < 2; ++i) v[rr][i] = *(const uint4*)(xb + (size_t)(row0 + rr) * D + (lane + 64 * i) * 8);
#pragma unroll
    for (int rr = 0; rr < 2; ++rr) {
      float f[2][8];
      float ss = 0.f;
#pragma unroll
      for (int i = 0; i < 2; ++i) {
        unpack8(v[rr][i], f[i]);
#pragma unroll
        for (int j = 0; j < 8; ++j) ss += f[i][j] * f[i][j];
      }
      ss = wave_sum(ss);
      const float rs = rsqrtf(ss * (1.f / 1024.f) + EPS);
      float* y = p.out + (size_t)(row0 + rr) * D;
#pragma unroll
      for (int i = 0; i < 2; ++i) {
        const int c0 = (lane + 64 * i) * 8;
        const float4 g0 = *(const float4*)(p.norm_f + c0), g1 = *(const float4*)(p.norm_f + c0 + 4);
        *(float4*)(y + c0) = make_float4(f[i][0] * rs * g0.x, f[i][1] * rs * g0.y, f[i][2] * rs * g0.z, f[i][3] * rs * g0.w);
        *(float4*)(y + c0 + 4) = make_float4(f[i][4] * rs * g1.x, f[i][5] * rs * g1.y, f[i][6] * rs * g1.z, f[i][7] * rs * g1.w);
      }
    }
  }
}

template <int PH>
DEV void run_phase(const P& p, char* smem, int vx = -1, int vl = 0) {
  char* ws = p.ws;
  GArgs g{};
  g.resid = p.out;
  if (PH == 0) phase0(p, smem);
  else if (PH == 1) {
    g.A = (const u16*)(ws + XB); g.lda = 1024; g.B = (const u16*)(ws + W_INA); g.K = 1024; g.ntn = 24; g.PM = 8;
    g.ss = (const float*)(ws + SS0); g.o16 = (u16*)(ws + ZB);
    gemm_phase<EPI_INA>(p, g, smem);
  } else if (PH == 2) phase2(p, smem);
  else if (PH == 3) phase3(p);
  else if (PH == 4) phase4(p, smem);
  else if (PH == 5) {
    g.A = (const u16*)(ws + YBO); g.lda = 1024; g.B = (const u16*)(ws + W_OUTA); g.K = 1024; g.ntn = 8; g.PM = 8;
    g.ssw = (float*)(ws + SS0 + SSSZ); g.o16 = (u16*)(ws + XB);
    g.skip_sample = 1;
    gemm_phase<EPI_RES>(p, g, smem);
  } else if (PH == 6) {
    g.A = (const u16*)(ws + XB); g.lda = 1024; g.B = (const u16*)(ws + W_GU0); g.K = 1024; g.ntn = 44; g.PM = 16;
    g.ss = (const float*)(ws + SS0 + SSSZ); g.o16 = (u16*)(ws + ZB);
    GArgs g2{};
    g2.resid = p.out;
    g2.A = (const u16*)(ws + ZB); g2.lda = 2816; g2.B = (const u16*)(ws + W_D0); g2.K = 2816; g2.ntn = 8; g2.PM = 8;
    g2.ssw = (float*)(ws + SS0 + 2 * SSSZ); g2.o16 = (u16*)(ws + XB);
    GArgs g0{};
    g0.resid = p.out;
    g0.A = (const u16*)(ws + YBO); g0.lda = 1024; g0.B = (const u16*)(ws + W_OUTA); g0.K = 1024; g0.ntn = 8; g0.PM = 8;
    g0.ssw = (float*)(ws + SS0 + SSSZ); g0.o16 = (u16*)(ws + XB);
    g.prev = &g0; g.prev_in = 0;
    g.next = &g2; g.cnt = (unsigned*)(ws + BARO) + 32;
    gemm_phase<EPI_GU>(p, g, smem);
  } else if (PH == 7) {
    g.A = (const u16*)(ws + ZB); g.lda = 2816; g.B = (const u16*)(ws + W_D0); g.K = 2816; g.ntn = 8; g.PM = 8;
    g.ssw = (float*)(ws + SS0 + 2 * SSSZ); g.o16 = (u16*)(ws + XB); g.skip_sample = 1;
    gemm_phase<EPI_RES>(p, g, smem);
  } else if (PH == 8) {
    g.A = (const u16*)(ws + XB); g.lda = 1024; g.B = (const u16*)(ws + W_INC); g.K = 1024; g.ntn = 16; g.PM = 8;
    g.ss = (const float*)(ws + SS0 + 2 * SSSZ); g.o16 = (u16*)(ws + ZB); g.o16b = (u16*)(ws + ZB + 33816576);
    g.lns = (float*)(ws + LNSO); g.lnq = (float*)(ws + LNQO);
    gemm_phase<EPI_INC>(p, g, smem);
  } else if (PH == 9) phase9(p, smem);
  else if (PH == 10) {
    g.A = (const u16*)(ws + YBO); g.lda = 1024; g.B = (const u16*)(ws + W_OUTC); g.K = 1024; g.ntn = 8; g.PM = 8;
    g.ssw = (float*)(ws + SS0 + 3 * SSSZ); g.o16 = (u16*)(ws + XB);
    g.skip_sample = 1;
    gemm_phase<EPI_RES>(p, g, smem);
  } else if (PH == 11) {
    g.A = (const u16*)(ws + XB); g.lda = 1024; g.B = (const u16*)(ws + W_GU1); g.K = 1024; g.ntn = 44; g.PM = 16;
    g.ss = (const float*)(ws + SS0 + 3 * SSSZ); g.o16 = (u16*)(ws + ZB);
    GArgs g2{};
    g2.resid = p.out;
    g2.A = (const u16*)(ws + ZB); g2.lda = 2816; g2.B = (const u16*)(ws + W_D1); g2.K = 2816; g2.ntn = 8; g2.PM = 8;
    g2.ssw = (float*)(ws + SS0 + 4 * SSSZ); g2.o16 = (u16*)(ws + XB);
    GArgs g0{};
    g0.resid = p.out;
    g0.A = (const u16*)(ws + YBO); g0.lda = 1024; g0.B = (const u16*)(ws + W_OUTC); g0.K = 1024; g0.ntn = 8; g0.PM = 8;
    g0.ssw = (float*)(ws + SS0 + 3 * SSSZ); g0.o16 = (u16*)(ws + XB);
    g.prev = &g0; g.prev_in = 0;
    g.next = &g2; g.cnt = (unsigned*)(ws + BARO) + 64;
    gemm_phase<EPI_GU>(p, g, smem);
  } else if (PH == 12) {
    g.A = (const u16*)(ws + ZB); g.lda = 2816; g.B = (const u16*)(ws + W_D1); g.K = 2816; g.ntn = 8; g.PM = 8;
    g.ssw = (float*)(ws + SS0 + 4 * SSSZ); g.o16 = (u16*)(ws + XB); g.skip_sample = 1;
    gemm_phase<EPI_RES>(p, g, smem);
  } else if (PH == 13) phase13(p);
}

#if FUSED
#define XB_TMO      128
#define XB_XCNT(j)  (256  + 64 * (j))
#define XB_XSUB(j)  (1280 + 64 * (j))
#define XB_XGEN(j)  (2304 + 64 * (j))
#define XB_TOP      3328
#define XB_TOPGEN   3392
#define XCD_BAR_WORDS 3456
#define XB_SPIN_CAP (1u << 22)
DEV unsigned xb_ld(unsigned* p) { return __hip_atomic_load(p, __ATOMIC_RELAXED, __HIP_MEMORY_SCOPE_AGENT); }
DEV unsigned xb_add(unsigned* p, unsigned v) { return __hip_atomic_fetch_add(p, v, __ATOMIC_RELAXED, __HIP_MEMORY_SCOPE_AGENT); }
DEV unsigned xb_xcc_id() { return (unsigned)__builtin_amdgcn_s_getreg((3 << 11) | 20) & 0xFu; }
#define XB_SPIN(cond, bar) do { unsigned _sp = 0; while (cond) { __builtin_amdgcn_s_sleep(1); \
    if ((++_sp & 255u) == 0u) { if (xb_ld(&(bar)[XB_TMO])) break; if (_sp > XB_SPIN_CAP) { atomicAdd(&(bar)[XB_TMO], 1u); break; } } } } while (0)
DEV void xb_complete(unsigned* bar, unsigned x, unsigned& nloc, unsigned& nx, unsigned& even) {
  const unsigned G = gridDim.x;
  unsigned sum, cnt, mine, sp = 0u;
  for (;;) {
    sum = 0u; cnt = 0u; mine = 0u; even = 1u;
#pragma unroll
    for (unsigned j = 0; j < 16; ++j) { const unsigned c = xb_ld(&bar[XB_XCNT(j)]); sum += c; cnt += (c > 0u) ? 1u : 0u; mine = (j == x) ? c : mine;
      if (j < 8 ? (c * 8u != G) : (c != 0u)) even = 0u; }
    if (sum == G) break;
    __builtin_amdgcn_s_sleep(1);
    if ((++sp & 255u) == 0u) { if (xb_ld(&bar[XB_TMO])) break; if (sp > XB_SPIN_CAP) { atomicAdd(&bar[XB_TMO], 1u); break; } }
  }
  nloc = mine > 0u ? mine : 1u; nx = cnt > 0u ? cnt : 1u;
}
DEV void gbar(unsigned* bar, unsigned x, unsigned& nloc, unsigned& nx, unsigned* evenp = nullptr) {
  asm volatile("s_waitcnt vmcnt(0)" ::: "memory");
  __syncthreads();
  if (threadIdx.x == 0) {
    __builtin_amdgcn_s_waitcnt(0);
    if (nloc == 0u) { unsigned ev; xb_complete(bar, x, nloc, nx, ev); if (evenp) *evenp = ev; }
    const unsigned old = xb_add(&bar[XB_XSUB(x)], 1u);
    const unsigned gen = old / nloc;
    if (old + 1u == (gen + 1u) * nloc) {
      __builtin_amdgcn_fence(__ATOMIC_RELEASE, "agent");
      asm volatile("s_waitcnt vmcnt(0)" ::: "memory");
      const unsigned og = xb_add(&bar[XB_TOP], 1u);
      const unsigned tg = og / nx;
      if (og + 1u == (tg + 1u) * nx) xb_add(&bar[XB_TOPGEN], 1u);
      else XB_SPIN(xb_ld(&bar[XB_TOPGEN]) == tg, bar);
      __builtin_amdgcn_fence(__ATOMIC_ACQUIRE, "agent");
      xb_add(&bar[XB_XGEN(x)], 1u);
      asm volatile("s_waitcnt vmcnt(0)" ::: "memory");
    } else {
      XB_SPIN(xb_ld(&bar[XB_XGEN(x)]) == gen, bar);
      __builtin_amdgcn_fence(__ATOMIC_ACQUIRE, "agent");
      asm volatile("s_waitcnt vmcnt(0)" ::: "memory");
    }
  }
  __syncthreads();
}
__global__ void __launch_bounds__(512, 2) mega(P p) {
  extern __shared__ __attribute__((aligned(16))) char smem[];
  cg::grid_group grid = cg::this_grid();
  unsigned* bar = (unsigned*)(p.ws + BARO);
  const unsigned xcc = xb_xcc_id();
  unsigned nloc = 0u, nx = 0u;
  if (threadIdx.x == 0) ((unsigned*)smem)[32767] = xb_add(&bar[XB_XCNT(xcc)], 1u);
  if (p.ws == nullptr) grid.sync();
  __syncthreads();
  const int rank = (int)((unsigned*)smem)[32767];
  __syncthreads();
  run_phase<0>(p, smem);
  gbar(bar, xcc, nloc, nx, (unsigned*)smem + 32766);
  const bool even = ((unsigned*)smem)[32766] != 0u;
  __syncthreads();
  const int vx = even ? (int)xcc : -1, vl = rank;
  run_phase<1>(p, smem, vx, vl); gbar(bar, xcc, nloc, nx);
  run_phase<2>(p, smem); gbar(bar, xcc, nloc, nx);
  if (gridDim.x == 256) {
    unsigned* gc = bar + 96 + (blockIdx.x >> 3);
    phase3(p, 1);
    handoff_publish(gc);
    phase3(p, 2);
    handoff_wait(gc, 8u);
    run_phase<4>(p, smem); gbar(bar, xcc, nloc, nx);
  } else {
    run_phase<3>(p, smem); gbar(bar, xcc, nloc, nx);
    run_phase<4>(p, smem); gbar(bar, xcc, nloc, nx);
  }
  run_phase<5>(p, smem, vx, vl); gbar(bar, xcc, nloc, nx);
  run_phase<6>(p, smem, vx, vl); gbar(bar, xcc, nloc, nx);
  run_phase<7>(p, smem, vx, vl); gbar(bar, xcc, nloc, nx);
  run_phase<8>(p, smem, vx, vl); gbar(bar, xcc, nloc, nx);
  run_phase<9>(p, smem); gbar(bar, xcc, nloc, nx);
  run_phase<10>(p, smem, vx, vl); gbar(bar, xcc, nloc, nx);
  run_phase<11>(p, smem, vx, vl); gbar(bar, xcc, nloc, nx);
  run_phase<12>(p, smem, vx, vl); gbar(bar, xcc, nloc, nx);
  run_phase<13>(p, smem);
}
#else
template <int PH>
__global__ void __launch_bounds__(256, 2) phase_kernel(P p) {
  __shared__ __attribute__((aligned(16))) char smem[65536];
  run_phase<PH>(p, smem);
}
#endif

extern "C" void kernel_launch(void* const* d_in, const int* in_sizes, int n_in, void* d_out, int out_size, void* d_ws,
                              size_t ws_size, hipStream_t stream) {
  P p{};
  const float** f = (const float**)&p;
  for (int i = 0; i < 27; ++i) f[i] = (const float*)d_in[i];
  p.out = (float*)d_out;
  p.ws = (char*)d_ws;
#if FUSED
  static int grid_blocks = 0;
  if (!grid_blocks) {
    int dev = 0, cus = 0, per_cu = 0;
    hipGetDevice(&dev);
    hipDeviceGetAttribute(&cus, hipDeviceAttributeMultiprocessorCount, dev);
    hipFuncSetAttribute((const void*)mega, hipFuncAttributeMaxDynamicSharedMemorySize, 131072 + 8192);
    hipOccupancyMaxActiveBlocksPerMultiprocessor(&per_cu, mega, 512, 131072 + 8192);
    if (per_cu > 1) per_cu = 1;
    grid_blocks = cus * per_cu;
  }
  hipMemsetAsync((char*)d_ws + BARO, 0, XCD_BAR_WORDS * 4, stream);
  void* args[] = {&p};
  hipError_t e = hipLaunchCooperativeKernel((void*)mega, dim3(grid_blocks), dim3(512), args, 131072 + 8192, stream);
  if (e != hipSuccess) fprintf(stderr, "cooperative launch failed: %s (grid %d)\n", hipGetErrorString(e), grid_blocks);
#else
  const int G = 512;
  phase_kernel<0><<<G, 256, 0, stream>>>(p);
  phase_kernel<1><<<G, 256, 0, stream>>>(p);
  phase_kernel<2><<<G, 256, 0, stream>>>(p);
  phase_kernel<3><<<G, 256, 0, stream>>>(p);
  phase_kernel<4><<<G, 256, 0, stream>>>(p);
  phase_kernel<5><<<G, 256, 0, stream>>>(p);
  phase_kernel<6><<<G, 256, 0, stream>>>(p);
  phase_kernel<7><<<G, 256, 0, stream>>>(p);
  phase_kernel<8><<<G, 256, 0, stream>>>(p);
  phase_kernel<9><<<G, 256, 0, stream>>>(p);
  phase_kernel<10><<<G, 256, 0, stream>>>(p);
  phase_kernel<11><<<G, 256, 0, stream>>>(p);
  phase_kernel<12><<<G, 256, 0, stream>>>(p);
  phase_kernel<13><<<G, 256, 0, stream>>>(p);
#endif
}
```

```cpp
#include <hip/hip_runtime.h>
#include <hip/hip_cooperative_groups.h>
#include <cstdio>
namespace cg = cooperative_groups;

#ifndef FUSED
#define FUSED 1
#endif

typedef unsigned short u16;
typedef __attribute__((ext_vector_type(8))) short bf16x8;
typedef __attribute__((ext_vector_type(4))) float f32x4;
#define DEV __device__ __forceinline__
__device__ __forceinline__ int tidx_() { int t = threadIdx.x; asm volatile("" : "+v"(t)); return t; }
#define VT (tidx_() & 255)
#define VHALF (tidx_() >> 8)
#define VBLK ((int)(blockIdx.x * 2) + (tidx_() >> 8))
#define VGRD ((int)(gridDim.x * 2))

constexpr int D = 1024, MP = 16384, MT = 129;
constexpr float EPS = 1e-6f;

constexpr size_t O_RETP = 16908288, O_RETS = 17432576, O_LRUP = 25821184, O_LRUS = 25825280,
                 O_CONVP = 25890816, O_CONVS = 25903104, O_SGUV = 26099712;
constexpr size_t W_INA = 0;
constexpr size_t W_OUTA = W_INA + 6291456;
constexpr size_t W_GU0 = W_OUTA + 2097152;
constexpr size_t W_D0 = W_GU0 + 11534336;
constexpr size_t W_INC = W_D0 + 5767168;
constexpr size_t W_OUTC = W_INC + 4194304;
constexpr size_t W_GU1 = W_OUTC + 2097152;
constexpr size_t W_D1 = W_GU1 + 11534336;
constexpr size_t XB = W_D1 + 5767168;
constexpr size_t ZB = XB + 33816576;
constexpr size_t YBO = ZB + 101449728;
constexpr size_t SSTO = YBO + 33816576;
constexpr size_t SS0 = SSTO + 16777216;
constexpr size_t SSSZ = 1056768;
constexpr size_t LNSO = SS0 + 5 * SSSZ;
constexpr size_t LNQO = LNSO + SSSZ;
constexpr size_t ROPEC = LNQO + SSSZ;
constexpr size_t ROPES = ROPEC + 524544;
constexpr size_t AGGP = ROPES + 524544;
constexpr size_t AGGH = AGGP + 262144;
constexpr size_t BARO = AGGH + 262144;
constexpr size_t UCO = BARO + 65536;

struct P {
  const float *x_prompt, *x_sample, *state_ret, *state_lru, *state_conv;
  const float *norm1, *norm2, *norm_f, *w_in_a, *ret_gn, *conv_w, *conv_b, *lru_wa, *lru_ba, *lru_wx, *lru_bx,
      *lru_lambda, *w_out_a, *w_in_c, *sg_norm_g, *sg_norm_b, *sg_ws, *sg_bs, *w_out_c, *ffn_wg, *ffn_wu, *ffn_wd;
  float* out;
  char* ws;
};

DEV void wconv_item(const P& p, float* tile, int tid, int item);
DEV u16 f2bf(float f) {
  unsigned u = __float_as_uint(f);
  u += 0x7fffu + ((u >> 16) & 1u);
  return (u16)(u >> 16);
}
DEV unsigned pk(float a, float b) { unsigned r; asm("v_cvt_pk_bf16_f32 %0, %1, %2" : "=v"(r) : "v"(a), "v"(b)); return r; }
DEV float blo(unsigned w) { return __uint_as_float(w << 16); }
DEV float bhi(unsigned w) { return __uint_as_float(w & 0xffff0000u); }
DEV float bf(u16 h) { return __uint_as_float(((unsigned)h) << 16); }
DEV void unpack8(uint4 v, float* f) {
  f[0] = blo(v.x); f[1] = bhi(v.x); f[2] = blo(v.y); f[3] = bhi(v.y);
  f[4] = blo(v.z); f[5] = bhi(v.z); f[6] = blo(v.w); f[7] = bhi(v.w);
}
DEV uint4 pack8(const float* f) { return make_uint4(pk(f[0], f[1]), pk(f[2], f[3]), pk(f[4], f[5]), pk(f[6], f[7])); }
DEV float wave_sum(float v) {
#pragma unroll
  for (int o = 32; o; o >>= 1) v += __shfl_xor(v, o);
  return v;
}
DEV float rcpf_(float x) { return __builtin_amdgcn_rcpf(x); }
DEV float sigmoidf_(float x) { return rcpf_(1.f + __expf(-x)); }
DEV float siluf_(float x) { return x * rcpf_(1.f + __expf(-x)); }
DEV float geluf_(float x) {
  float y2 = 1.5957691216057308f * (x + 0.044715f * x * x * x);
  return x * rcpf_(1.f + __expf(-y2));
}
DEV float lgh(int h) { return log1pf(-exp2f(-5.f - (float)h)); }

DEV int toff8(int row, int chunk) { return row * 128 + ((chunk ^ ((row >> 1) & 7)) << 4); }
DEV int toff16(int row, int chunk) { return row * 256 + ((chunk ^ (row & 15)) << 4); }
DEV int xoff(int t, int ch) { return t * 256 + ((((ch >> 2) ^ (t & 15))) << 4) + ((ch & 3) << 2); }
DEV int ooff(int i, int e) { return i * 512 + ((((e >> 2) ^ (i & 31))) << 4) + ((e & 3) << 2); }

template <int KC>
DEV void mma_tile(f32x4 (&acc)[4][4], const char* sA, const char* sB, int wm, int wn, int lane) {
  const int r = lane & 15, q = lane >> 4;
#pragma unroll KC == 8 ? 2 : 1
  for (int ks = 0; ks < KC / 4; ++ks) {
    bf16x8 a[4], b[4];
#pragma unroll
    for (int i = 0; i < 4; ++i) {
      int ra = wm * 64 + i * 16 + r, rb = wn * 64 + i * 16 + r;
      if (KC == 8) {
        a[i] = *(const bf16x8*)(sA + toff8(ra, ks * 4 + q));
        b[i] = *(const bf16x8*)(sB + toff8(rb, ks * 4 + q));
      } else {
        a[i] = *(const bf16x8*)(sA + toff16(ra, ks * 4 + q));
        b[i] = *(const bf16x8*)(sB + toff16(rb, ks * 4 + q));
      }
    }
#pragma unroll
    for (int mi = 0; mi < 4; ++mi)
#pragma unroll
      for (int ni = 0; ni < 4; ++ni)
        acc[mi][ni] = __builtin_amdgcn_mfma_f32_16x16x32_bf16(b[ni], a[mi], acc[mi][ni], 0, 0, 0);
  }
}

DEV void zero_acc(f32x4 (&acc)[4][4]) {
#pragma unroll
  for (int i = 0; i < 4; ++i)
#pragma unroll
    for (int j = 0; j < 4; ++j) acc[i][j] = f32x4{0.f, 0.f, 0.f, 0.f};
}

DEV float rstd16(const float* ss, int row) {
  const float4* s = (const float4*)(ss + (size_t)row * 16);
  float4 a = s[0], b = s[1], c = s[2], d = s[3];
  float t = (a.x + a.y + a.z + a.w) + (b.x + b.y + b.z + b.w) + (c.x + c.y + c.z + c.w) + (d.x + d.y + d.z + d.w);
  return rsqrtf(t * (1.f / 1024.f) + EPS);
}
DEV float rstd16_q(const float* ss, int row, int fq) {
  const float4 a = *(const float4*)(ss + (size_t)row * 16 + fq * 4);
  float t = (a.x + a.y) + (a.z + a.w);
  t += __shfl_xor(t, 16);
  t += __shfl_xor(t, 32);
  return rsqrtf(t * (1.f / 1024.f) + EPS);
}
DEV float sum16(const float* ss, int row) {
  const float4* s = (const float4*)(ss + (size_t)row * 16);
  float4 a = s[0], b = s[1], c = s[2], d = s[3];
  return (a.x + a.y + a.z + a.w) + (b.x + b.y + b.z + b.w) + (c.x + c.y + c.z + c.w) + (d.x + d.y + d.z + d.w);
}

enum { EPI_INA = 0, EPI_RES_IN, EPI_RES, EPI_GU, EPI_INC };

struct GArgs {
  const u16* A; int lda; const u16* B; int K; int ntn; int PM; int vx, vl;
  const float* ss;
  float* ssw;
  u16* o16;
  u16* o16b;
  float* resid;
  float* lns; float* lnq;
  const GArgs* next;
  const GArgs* prev;
  int prev_in;
  unsigned* cnt;
  int skip_sample;
  int wc_lo, wc_hi;
};

template <int EPI>
DEV void gemm_tile8(const P& p, const GArgs& g, char* smem, int tn) {
  const int tid = tidx_(), lane = tid & 63, w = tid >> 6, wm = w >> 1, wn = w & 1;
  const int r = lane & 15, q = lane >> 4;
  f32x4 acc[2][4];
#pragma unroll
  for (int i = 0; i < 2; ++i)
#pragma unroll
    for (int j = 0; j < 4; ++j) acc[i][j] = f32x4{0.f, 0.f, 0.f, 0.f};
  const u16* ga = g.A + (size_t)MP * g.lda;
  const u16* gb = EPI == EPI_GU ? g.B : g.B + (size_t)(tn * 128) * g.K;
  size_t goa[2], gob[2];
  int lof[2];
#pragma unroll
  for (int i = 0; i < 2; ++i) {
    const int R = (i * 8 + w) * 8, row = R + (lane >> 3), chunk = (lane & 7) ^ ((row >> 1) & 7);
    goa[i] = (size_t)row * g.lda + chunk * 8;
    const int brow = EPI == EPI_GU ? ((tn >> 1) * 256 + (tn & 1) * 64 + ((row >> 5) << 4) + (row & 15) + ((row >> 4) & 1) * 128) : row;
    gob[i] = (size_t)brow * g.K + chunk * 8;
    lof[i] = R * 128 + lane * 16;
  }
  const int nk = g.K >> 6;
#define T8_ISSUE(kt_) do { char* d_ = smem + ((kt_) & 3) * 32768; const u16* pa_ = ga + (kt_) * 64; const u16* pb_ = gb + (kt_) * 64; \
    _Pragma("unroll") for (int i = 0; i < 2; ++i) { \
      __builtin_amdgcn_global_load_lds((const unsigned*)(pa_ + goa[i]), (unsigned*)(d_ + lof[i]), 16, 0, 0); \
      __builtin_amdgcn_global_load_lds((const unsigned*)(pb_ + gob[i]), (unsigned*)(d_ + 16384 + lof[i]), 16, 0, 0); } } while (0)
  T8_ISSUE(0); T8_ISSUE(1); T8_ISSUE(2);
  for (int kt = 0; kt < nk; ++kt) {
    if (kt + 2 < nk) asm volatile("s_waitcnt vmcnt(8)" ::: "memory");
    else if (kt + 1 < nk) asm volatile("s_waitcnt vmcnt(4)" ::: "memory");
    else asm volatile("s_waitcnt vmcnt(0)" ::: "memory");
    __builtin_amdgcn_s_barrier();
    asm volatile("" ::: "memory");
    if (kt + 3 < nk) T8_ISSUE(kt + 3);
    const char* sA = smem + (kt & 3) * 32768; const char* sB = sA + 16384;
#pragma unroll
    for (int ks = 0; ks < 2; ++ks) {
      bf16x8 a[2], b[4];
#pragma unroll
      for (int i = 0; i < 2; ++i) a[i] = *(const bf16x8*)(sA + toff8(wm * 32 + i * 16 + r, ks * 4 + q));
#pragma unroll
      for (int i = 0; i < 4; ++i) b[i] = *(const bf16x8*)(sB + toff8(wn * 64 + i * 16 + r, ks * 4 + q));
#pragma unroll
      for (int mi = 0; mi < 2; ++mi)
#pragma unroll
        for (int ni = 0; ni < 4; ++ni)
          acc[mi][ni] = __builtin_amdgcn_mfma_f32_16x16x32_bf16(b[ni], a[mi], acc[mi][ni], 0, 0, 0);
    }
  }
#undef T8_ISSUE
  asm volatile("s_waitcnt vmcnt(0) lgkmcnt(0)" ::: "memory");
  __builtin_amdgcn_s_barrier();
#pragma unroll
  for (int mi = 0; mi < 2; ++mi) {
    const int row = MP + wm * 32 + mi * 16 + r;
    if (EPI == EPI_INA) {
      const float rs = rstd16(g.ss, row);
#pragma unroll
      for (int ni = 0; ni < 4; ++ni) {
        const int col = tn * 128 + wn * 64 + ni * 16 + q * 4;
        f32x4 v = acc[mi][ni] * rs;
        *(uint2*)(g.o16 + (size_t)row * 3072 + col) = make_uint2(pk(v[0], v[1]), pk(v[2], v[3]));
      }
    } else if (EPI == EPI_RES_IN || EPI == EPI_RES) {
      float* xo = g.resid + (size_t)row * D;
      const float* xi = xo;
      if (EPI == EPI_RES_IN) xi = row < MP ? p.x_prompt + (size_t)row * D : p.x_sample + (size_t)(row - MP) * D;
      float ssum = 0.f;
#pragma unroll
      for (int ni = 0; ni < 4; ++ni) {
        const int col = tn * 128 + wn * 64 + ni * 16 + q * 4;
        float4 o;
        if (EPI == EPI_RES_IN) o = *(const float4*)(xi + col);
        else { const uint2 t = *(const uint2*)((const u16*)(p.ws + XB) + (size_t)row * D + col); o = make_float4(blo(t.x), bhi(t.x), blo(t.y), bhi(t.y)); }
        f32x4 a = acc[mi][ni];
        o.x += a[0]; o.y += a[1]; o.z += a[2]; o.w += a[3];
        ssum += o.x * o.x + o.y * o.y + o.z * o.z + o.w * o.w;
        if (g.o16) *(uint2*)(g.o16 + (size_t)row * D + col) = make_uint2(pk(o.x, o.y), pk(o.z, o.w));
        else *(float4*)(xo + col) = o;
      }
      ssum += __shfl_xor(ssum, 16);
      ssum += __shfl_xor(ssum, 32);
      if (q == 0 && g.o16) g.ssw[(size_t)row * 16 + tn * 2 + wn] = ssum;
    } else if (EPI == EPI_GU) {
      const float rs = rstd16(g.ss, row);
#pragma unroll
      for (int pp = 0; pp < 2; ++pp) {
        f32x4 gg = acc[mi][2 * pp] * rs, uu = acc[mi][2 * pp + 1] * rs;
        float o[4];
#pragma unroll
        for (int j = 0; j < 4; ++j) o[j] = siluf_(gg[j]) * uu[j];
        const int col = tn * 64 + wn * 32 + pp * 16 + q * 4;
        *(uint2*)(g.o16 + (size_t)row * 2816 + col) = make_uint2(pk(o[0], o[1]), pk(o[2], o[3]));
      }
    } else if (EPI == EPI_INC) {
      const float rs = rstd16(g.ss, row);
      float s1 = 0.f, s2 = 0.f;
#pragma unroll
      for (int ni = 0; ni < 4; ++ni) {
        const int col = tn * 128 + wn * 64 + ni * 16 + q * 4;
        f32x4 v = acc[mi][ni] * rs;
        float o[4];
#pragma unroll
        for (int j = 0; j < 4; ++j) { o[j] = geluf_(v[j]); s1 += o[j]; s2 += o[j] * o[j]; }
        u16* dst = tn < 8 ? g.o16 + (size_t)row * D + col : g.o16b + (size_t)row * D + (col - 1024);
        *(uint2*)dst = make_uint2(pk(o[0], o[1]), pk(o[2], o[3]));
      }
      if (tn >= 8) {
        s1 += __shfl_xor(s1, 16); s1 += __shfl_xor(s1, 32);
        s2 += __shfl_xor(s2, 16); s2 += __shfl_xor(s2, 32);
        if (q == 0) {
          g.lns[(size_t)row * 16 + (tn - 8) * 2 + wn] = s1;
          g.lnq[(size_t)row * 16 + (tn - 8) * 2 + wn] = s2;
        }
      }
    }
  }
}

namespace pg8 {
#define PG8_LAS __attribute__((address_space(3)))
constexpr int BM = 256, BK = 64, HALF = 128, HTB = HALF * BK * 2, NXCD = 8, WGM = 8;
DEV int lds_byte(int r, int c) { const int st = (r >> 4) * 2 + (c >> 5), rr = r & 15, cc = c & 31, ob = rr * 64 + cc * 2; return st * 1024 + (ob ^ (((ob >> 9) & 1) << 5)); }
DEV void stage_rc(int b, int& R, int& C) { const int st = b / 1024, sb = b % 1024, swz = sb ^ (((sb >> 9) & 1) << 5); R = (st >> 1) * 16 + swz / 64; C = (st & 1) * 32 + (swz % 64) / 2; }
DEV int perm32(int rho) { const int n = rho >> 4, i = rho & 15; return 8 * (i >> 2) + 4 * n + (i & 3); }
struct Unit { int pm, pn; };
struct Gemm { const u16* A; const u16* Bt; int M, N, K; };
struct StaticOrder {
  int nM, nN, nwg, G, c;
  DEV void init(int M, int N, int G_, int c_) { nM = M / BM; nN = N / BM; nwg = nM * nN; G = G_; c = c_; }
  DEV bool next(int i, Unit& u) const {
    const long L = (long)i * G + c; if (L >= nwg) return false;
    int wgid = (int)L; { const int q = nwg / NXCD, r = nwg % NXCD, xcd = wgid % NXCD, off = wgid / NXCD; wgid = (xcd < r ? xcd * (q + 1) : r * (q + 1) + (xcd - r) * q) + off; }
    const int nig = WGM * nN, gid = wgid / nig, fm = gid * WGM, gsz = (nM - fm) < WGM ? (nM - fm) : WGM;
    u.pm = fm + ((wgid % nig) % gsz); u.pn = (wgid % nig) / gsz; return true;
  }
};
template <class Epi, class Sched>
DEV void gemm_phase(PG8_LAS unsigned char* lds, const Gemm g, const Sched& S, const Epi& E) {
  const int tid = threadIdx.x, wid = __builtin_amdgcn_readfirstlane(tid >> 6), lane = tid & 63, wr = wid >> 2, wc = wid & 3, fr = lane & 15, fq = lane >> 4;
  const int K = g.K, nt = K / BK;
  unsigned voffA[2], voffB[2];
#pragma unroll
  for (int i = 0; i < 2; ++i) { int R, C; stage_rc(tid * 16 + i * 8192, R, C); const int Rb = Epi::PERM ? ((R & ~31) + perm32(R & 31)) : R;
    voffA[i] = (unsigned)(R * K + C) * 2u; voffB[i] = (unsigned)(Rb * K + C) * 2u; }
  const size_t kstep = (size_t)(BK * 2);
  const size_t hstep = (size_t)HALF * K * 2;
  const size_t tstep = 2 * hstep;
  const unsigned ldsw = (unsigned)wid * 1024u;
  const int aoff = lds_byte(wr * 64 + fr, fq * 8), boff = lds_byte(wc * 32 + fr, fq * 8);
#define PG8_SA(b, h) (((b) * 2 + (h)) * HTB)
#define PG8_SB(b, h) ((4 + (b) * 2 + (h)) * HTB)
#define PG8_STAGE(bufoff, gbase, voff) do { _Pragma("unroll") for (int _i = 0; _i < 2; ++_i) \
    __builtin_amdgcn_global_load_lds((const unsigned*)((const char*)(gbase) + (voff)[_i]), (PG8_LAS unsigned*)(lds + (bufoff) + ldsw + _i * 8192), 16, 0, 0); } while (0)
#define PG8_LDA(dst, b, h) do { _Pragma("unroll") for (int m = 0; m < 4; ++m) _Pragma("unroll") for (int k = 0; k < 2; ++k) dst[m][k] = *(const PG8_LAS bf16x8*)(lds + PG8_SA(b, h) + aoff + m * 2048 + k * 1024); } while (0)
#define PG8_LDB(dst, b, h) do { _Pragma("unroll") for (int n = 0; n < 2; ++n) _Pragma("unroll") for (int k = 0; k < 2; ++k) dst[n][k] = *(const PG8_LAS bf16x8*)(lds + PG8_SB(b, h) + boff + n * 2048 + k * 1024); } while (0)
#define PG8_MMA(ai, bj, At, Bt) do { __builtin_amdgcn_s_setprio(1); _Pragma("unroll") for (int m = 0; m < 4; ++m) _Pragma("unroll") for (int n = 0; n < 2; ++n) _Pragma("unroll") for (int k = 0; k < 2; ++k) \
    acc[ai][bj][m][n] = __builtin_amdgcn_mfma_f32_16x16x32_bf16(Bt[n][k], At[m][k], acc[ai][bj][m][n], 0, 0, 0); __builtin_amdgcn_s_setprio(0); } while (0)
#define PG8_WAIT_V(n) asm volatile("s_waitcnt vmcnt(" #n ")" ::: "memory")
#define PG8_WAIT_L(n) asm volatile("s_waitcnt lgkmcnt(" #n ")" ::: "memory")
#define PG8_BAR __builtin_amdgcn_s_barrier()
#define PG8_SCHED __builtin_amdgcn_sched_barrier(0)
  Unit cur, nxt; int ui = 0;
  if (!S.next(0, cur)) return;
  f32x4 acc[2][2][4][2];
#pragma unroll
  for (int a = 0; a < 2; ++a)
#pragma unroll
    for (int b = 0; b < 2; ++b)
#pragma unroll
      for (int m = 0; m < 4; ++m)
#pragma unroll
        for (int n = 0; n < 2; ++n) acc[a][b][m][n] = (f32x4){0.f, 0.f, 0.f, 0.f};
  bf16x8 At[4][2], B0[2][2], B1[2][2];
  const char* cA = (const char*)g.A + (size_t)cur.pm * tstep; const char* cB = (const char*)g.Bt + (size_t)cur.pn * tstep;
  PG8_STAGE(PG8_SB(0, 0), cB, voffB); PG8_STAGE(PG8_SA(0, 0), cA, voffA); PG8_STAGE(PG8_SB(0, 1), cB + hstep, voffB); PG8_STAGE(PG8_SA(0, 1), cA + hstep, voffA);
  if (wr == 1) PG8_BAR;
  PG8_WAIT_V(4); PG8_BAR;
  PG8_STAGE(PG8_SB(1, 0), cB + kstep, voffB); PG8_STAGE(PG8_SA(1, 0), cA + kstep, voffA); PG8_STAGE(PG8_SB(1, 1), cB + hstep + kstep, voffB);
  PG8_WAIT_V(6); PG8_BAR;
  for (;;) {
    const bool has_next = S.next(ui + 1, nxt);
    const char* nA = has_next ? (const char*)g.A + (size_t)nxt.pm * tstep : cA; const char* nB = has_next ? (const char*)g.Bt + (size_t)nxt.pn * tstep : cB;
    for (int t = 0; t < nt; t += 2) {
      const bool last = (t == nt - 2);
      const char* a1 = cA + (size_t)(t + 1) * kstep;
      const char* a2 = last ? nA : cA + (size_t)(t + 2) * kstep; const char* b2 = last ? nB : cB + (size_t)(t + 2) * kstep;
      const char* a3 = a2 + kstep; const char* b3 = b2 + kstep;
      PG8_LDB(B0, 0, 0); PG8_SCHED; PG8_LDA(At, 0, 0); PG8_STAGE(PG8_SA(1, 1), a1 + hstep, voffA);
      PG8_WAIT_L(8); PG8_BAR; PG8_WAIT_L(0); PG8_MMA(0, 0, At, B0); PG8_BAR; PG8_SCHED;
      PG8_LDB(B1, 0, 1); PG8_STAGE(PG8_SB(0, 0), b2, voffB);
      PG8_BAR; PG8_WAIT_L(0); PG8_MMA(0, 1, At, B1); PG8_BAR;
      PG8_LDA(At, 0, 1); PG8_STAGE(PG8_SA(0, 0), a2, voffA);
      PG8_BAR; PG8_WAIT_L(0); PG8_MMA(1, 0, At, B0); PG8_BAR; PG8_SCHED;
      PG8_STAGE(PG8_SB(0, 1), b2 + hstep, voffB);
      PG8_WAIT_V(6); PG8_BAR; PG8_MMA(1, 1, At, B1); PG8_BAR;
      PG8_LDB(B0, 1, 0); PG8_SCHED; PG8_LDA(At, 1, 0); PG8_STAGE(PG8_SA(0, 1), a2 + hstep, voffA);
      PG8_WAIT_L(8); PG8_BAR; PG8_WAIT_L(0); PG8_MMA(0, 0, At, B0); PG8_BAR; PG8_SCHED;
      PG8_LDB(B1, 1, 1); PG8_STAGE(PG8_SB(1, 0), b3, voffB);
      PG8_BAR; PG8_WAIT_L(0); PG8_MMA(0, 1, At, B1); PG8_BAR;
      PG8_LDA(At, 1, 1); PG8_STAGE(PG8_SA(1, 0), a3, voffA);
      PG8_BAR; PG8_WAIT_L(0); PG8_MMA(1, 0, At, B0); PG8_BAR; PG8_SCHED;
      PG8_STAGE(PG8_SB(1, 1), b3 + hstep, voffB);
      PG8_WAIT_V(6); PG8_BAR; PG8_MMA(1, 1, At, B1); PG8_BAR;
    }
    E(acc, cur, ui, wr, wc, fr, fq);
    if (!has_next) break;
#pragma unroll
    for (int a = 0; a < 2; ++a)
#pragma unroll
      for (int b = 0; b < 2; ++b)
#pragma unroll
        for (int m = 0; m < 4; ++m)
#pragma unroll
          for (int n = 0; n < 2; ++n) acc[a][b][m][n] = (f32x4){0.f, 0.f, 0.f, 0.f};
    cur = nxt; cA = nA; cB = nB; ++ui;
  }
  PG8_WAIT_V(0);
  if (wr == 0) PG8_BAR;
  PG8_BAR;
#undef PG8_SA
#undef PG8_SB
#undef PG8_STAGE
#undef PG8_LDA
#undef PG8_LDB
#undef PG8_MMA
#undef PG8_WAIT_V
#undef PG8_WAIT_L
#undef PG8_BAR
#undef PG8_SCHED
}
}

template <int EPI>
struct Epi8 {
  static constexpr bool PERM = true;
  GArgs g; const P* p;
  const PG8_LAS float* rsl;
  DEV void operator()(const f32x4 (&acc)[2][2][4][2], const pg8::Unit& u, int ui, int wr, int wc, int fr, int fq) const {
    const int rbase = u.pm * 256 + wr * 64 + fr;
    float rsv[2][4];
    if (EPI == EPI_INA || EPI == EPI_GU || EPI == EPI_INC) {
#pragma unroll
      for (int ai = 0; ai < 2; ++ai)
#pragma unroll
        for (int m = 0; m < 4; ++m) rsv[ai][m] = rsl[ui * 256 + ai * 128 + wr * 64 + m * 16 + fr];
    }
#pragma unroll
    for (int ai = 0; ai < 2; ++ai) {
      if (EPI == EPI_RES_IN || EPI == EPI_RES) {
        float o[4][2][8];
        if (EPI == EPI_RES_IN) {
          float4 x4[4][2][2];
#pragma unroll
          for (int m = 0; m < 4; ++m)
#pragma unroll
            for (int bj = 0; bj < 2; ++bj) {
              const float* xp = p->x_prompt + (size_t)(rbase + ai * 128 + m * 16) * D + u.pn * 256 + bj * 128 + wc * 32 + 8 * fq;
              x4[m][bj][0] = *(const float4*)xp; x4[m][bj][1] = *(const float4*)(xp + 4);
            }
          asm volatile("s_waitcnt vmcnt(0)" ::: "memory");
#pragma unroll
          for (int m = 0; m < 4; ++m)
#pragma unroll
            for (int bj = 0; bj < 2; ++bj) {
              o[m][bj][0] = x4[m][bj][0].x; o[m][bj][1] = x4[m][bj][0].y; o[m][bj][2] = x4[m][bj][0].z; o[m][bj][3] = x4[m][bj][0].w;
              o[m][bj][4] = x4[m][bj][1].x; o[m][bj][5] = x4[m][bj][1].y; o[m][bj][6] = x4[m][bj][1].z; o[m][bj][7] = x4[m][bj][1].w;
            }
        } else {
          uint4 x8[4][2];
#pragma unroll
          for (int m = 0; m < 4; ++m)
#pragma unroll
            for (int bj = 0; bj < 2; ++bj)
              x8[m][bj] = *(const uint4*)((const u16*)(p->ws + XB) + (size_t)(rbase + ai * 128 + m * 16) * D + u.pn * 256 + bj * 128 + wc * 32 + 8 * fq);
          asm volatile("s_waitcnt vmcnt(0)" ::: "memory");
#pragma unroll
          for (int m = 0; m < 4; ++m)
#pragma unroll
            for (int bj = 0; bj < 2; ++bj) unpack8(x8[m][bj], o[m][bj]);
        }
#pragma unroll
        for (int m = 0; m < 4; ++m) {
          const int row = rbase + ai * 128 + m * 16;
          float ssum = 0.f;
#pragma unroll
          for (int bj = 0; bj < 2; ++bj) {
            const int col0 = u.pn * 256 + bj * 128 + wc * 32 + 8 * fq;
            const f32x4 a0 = acc[ai][bj][m][0], a1 = acc[ai][bj][m][1];
#pragma unroll
            for (int j = 0; j < 4; ++j) { o[m][bj][j] += a0[j]; o[m][bj][4 + j] += a1[j]; }
#pragma unroll
            for (int j = 0; j < 8; ++j) ssum += o[m][bj][j] * o[m][bj][j];
            *(uint4*)(g.o16 + (size_t)row * D + col0) = pack8(o[m][bj]);
          }
          ssum += __shfl_xor(ssum, 16);
          ssum += __shfl_xor(ssum, 32);
          if (fq == 0) g.ssw[(size_t)row * 16 + u.pn * 4 + wc] = ssum;
        }
      } else {
#pragma unroll
        for (int m = 0; m < 4; ++m) {
          const int row = rbase + ai * 128 + m * 16;
          const float rs = rsv[ai][m];
          if (EPI == EPI_INA) {
#pragma unroll
            for (int bj = 0; bj < 2; ++bj) {
              const int col0 = u.pn * 256 + bj * 128 + wc * 32 + 8 * fq;
              f32x4 v0 = acc[ai][bj][m][0] * rs, v1 = acc[ai][bj][m][1] * rs;
              *(uint4*)(g.o16 + (size_t)row * 3072 + col0) = make_uint4(pk(v0[0], v0[1]), pk(v0[2], v0[3]), pk(v1[0], v1[1]), pk(v1[2], v1[3]));
            }
          } else if (EPI == EPI_GU) {
            const f32x4 g0 = acc[ai][0][m][0] * rs, g1 = acc[ai][0][m][1] * rs, u0 = acc[ai][1][m][0] * rs, u1 = acc[ai][1][m][1] * rs;
            float o[8];
#pragma unroll
            for (int j = 0; j < 4; ++j) { o[j] = siluf_(g0[j]) * u0[j]; o[4 + j] = siluf_(g1[j]) * u1[j]; }
            const int col = u.pn * 128 + wc * 32 + 8 * fq;
            *(uint4*)(g.o16 + (size_t)row * 2816 + col) = pack8(o);
          } else if (EPI == EPI_INC) {
            float s1 = 0.f, s2 = 0.f;
#pragma unroll
            for (int bj = 0; bj < 2; ++bj) {
              const int col0 = u.pn * 256 + bj * 128 + wc * 32 + 8 * fq;
              f32x4 v0 = acc[ai][bj][m][0] * rs, v1 = acc[ai][bj][m][1] * rs;
              float o[8];
#pragma unroll
              for (int j = 0; j < 4; ++j) { o[j] = geluf_(v0[j]); o[4 + j] = geluf_(v1[j]); }
#pragma unroll
              for (int j = 0; j < 8; ++j) { s1 += o[j]; s2 += o[j] * o[j]; }
              u16* dst = u.pn < 4 ? g.o16 + (size_t)row * D + col0 : g.o16b + (size_t)row * D + (col0 - 1024);
              *(uint4*)dst = pack8(o);
            }
            if (u.pn >= 4) {
              s1 += __shfl_xor(s1, 16); s1 += __shfl_xor(s1, 32);
              s2 += __shfl_xor(s2, 16); s2 += __shfl_xor(s2, 32);
              if (fq == 0) {
                g.lns[(size_t)row * 16 + (u.pn - 4) * 4 + wc] = s1;
                g.lnq[(size_t)row * 16 + (u.pn - 4) * 4 + wc] = s2;
              }
            }
          }
        }
      }
    }
  }
};

DEV void handoff_publish(unsigned* cnt) {
  asm volatile("s_waitcnt vmcnt(0)" ::: "memory");
  __syncthreads();
  if (threadIdx.x == 0) {
    __builtin_amdgcn_fence(__ATOMIC_RELEASE, "agent");
    asm volatile("s_waitcnt vmcnt(0)" ::: "memory");
    __hip_atomic_fetch_add(cnt, 1u, __ATOMIC_RELAXED, __HIP_MEMORY_SCOPE_AGENT);
  }
  __syncthreads();
}
DEV void handoff_wait(unsigned* cnt, unsigned need) {
  if (threadIdx.x == 0) {
    unsigned sp = 0;
    while (__hip_atomic_load(cnt, __ATOMIC_RELAXED, __HIP_MEMORY_SCOPE_AGENT) < need) {
      __builtin_amdgcn_s_sleep(2);
      if (++sp > (1u << 22)) break;
    }
    __builtin_amdgcn_fence(__ATOMIC_ACQUIRE, "agent");
    asm volatile("s_waitcnt vmcnt(0)" ::: "memory");
  }
  __syncthreads();
}

template <int EPI>
__device__ void gemm_phase(const P& p, const GArgs& g, char* smem) {
  const int j = (int)gridDim.x - 1 - (int)blockIdx.x;
  const bool chain = (EPI == EPI_GU) && g.next != nullptr;
  if (chain) {
    const int jp = j - g.ntn - g.next->ntn;
    if (jp >= 0 && jp < g.prev->ntn) {
      if (g.prev_in) gemm_tile8<EPI_RES_IN>(p, *g.prev, smem, jp);
      else gemm_tile8<EPI_RES>(p, *g.prev, smem, jp);
      handoff_publish(g.cnt);
    }
    if (j < g.ntn) {
      handoff_wait(g.cnt, (unsigned)g.prev->ntn);
      gemm_tile8<EPI>(p, g, smem, j);
      handoff_publish(g.cnt + 16);
    }
  }
  {
    pg8::Gemm gm{g.A, g.B, MP, g.ntn * 128, g.K};
    pg8::StaticOrder S;
    S.init(MP, g.ntn * 128, (int)gridDim.x, (int)blockIdx.x);
    PG8_LAS float* rsl = (PG8_LAS float*)((PG8_LAS unsigned char*)smem + 131072);
    if (EPI == EPI_INA || EPI == EPI_GU || EPI == EPI_INC) {
      const int t = tidx_();
      pg8::Unit u0;
      for (int i = (t >> 8); S.next(i, u0); i += 2) rsl[i * 256 + (t & 255)] = rstd16(g.ss, u0.pm * 256 + (t & 255));
      __syncthreads();
    }
    Epi8<EPI> E{g, &p, rsl};
    pg8::gemm_phase(( PG8_LAS unsigned char*)smem, gm, S, E);
  }
  if (chain) {
    if (j >= g.ntn && j < g.ntn + g.next->ntn) {
      handoff_wait(g.cnt + 16, (unsigned)g.ntn);
      gemm_tile8<EPI_RES>(p, *g.next, smem, j - g.ntn);
    } else if (j >= 60 && j < 128) {
      const int vb = (j - 60) * 2 + VHALF;
      float* tile = (float*)(smem + VHALF * 65536);
      const int tidl = VT;
      for (int it = g.wc_lo + vb; it < g.wc_hi; it += 136) wconv_item(p, tile, tidl, it);
    }
  } else if (!g.skip_sample) {
    if (j < g.ntn) gemm_tile8<EPI>(p, g, smem, j);
  }
}

DEV void wconv_item(const P& p, float* tile, int tid, int item) {
  int it = item;
  const float* src; const float* gain = nullptr; int K = 1024, N = 1024, mode = 0; size_t dsto;
  if (it < 384) { src = p.w_in_a; N = 3072; gain = p.norm1; dsto = W_INA; }
  else if ((it -= 384) < 128) { src = p.w_out_a; dsto = W_OUTA; }
  else if ((it -= 128) < 352) { src = p.ffn_wg; N = 2816; gain = p.norm2; dsto = W_GU0; mode = 1; }
  else if ((it -= 352) < 352) { src = p.ffn_wu; N = 2816; gain = p.norm2; dsto = W_GU0; mode = 2; }
  else if ((it -= 352) < 352) { src = p.ffn_wd; K = 2816; dsto = W_D0; }
  else if ((it -= 352) < 256) { src = p.w_in_c; N = 2048; gain = p.norm1 + 1024; dsto = W_INC; }
  else if ((it -= 256) < 128) { src = p.w_out_c; dsto = W_OUTC; }
  else if ((it -= 128) < 352) { src = p.ffn_wg + (size_t)1024 * 2816; N = 2816; gain = p.norm2 + 1024; dsto = W_GU1; mode = 1; }
  else if ((it -= 352) < 352) { src = p.ffn_wu + (size_t)1024 * 2816; N = 2816; gain = p.norm2 + 1024; dsto = W_GU1; mode = 2; }
  else { it -= 352; src = p.ffn_wd + (size_t)2816 * 1024; K = 2816; dsto = W_D1; }
  u16* dst = (u16*)(p.ws + dsto);
  const int ntn = N >> 7;
  const int kt = it / ntn, nt = it - kt * ntn, k0 = kt * 64, n0 = nt * 128;
  {
    const int nn = tid & 127, kh = tid >> 7;
    float v[32];
#pragma unroll
    for (int i = 0; i < 32; ++i) v[i] = src[(size_t)(k0 + kh + 2 * i) * N + n0 + nn];
    if (gain) {
#pragma unroll
      for (int i = 0; i < 32; ++i) v[i] *= gain[k0 + kh + 2 * i];
    }
#pragma unroll
    for (int i = 0; i < 32; ++i) tile[(kh + 2 * i) * 129 + nn] = v[i];
  }
  __syncthreads();
  {
    const int nn = tid >> 1, kc = (tid & 1) * 32;
    unsigned wv[16];
#pragma unroll
    for (int j = 0; j < 16; ++j) wv[j] = pk(tile[(kc + 2 * j) * 129 + nn], tile[(kc + 2 * j + 1) * 129 + nn]);
    const int n = n0 + nn;
    const int drow = mode == 0 ? n : ((n >> 7) * 256 + (n & 127) + (mode == 2 ? 128 : 0));
    uint4* d = (uint4*)(dst + (size_t)drow * K + k0 + kc);
    d[0] = make_uint4(wv[0], wv[1], wv[2], wv[3]);
    d[1] = make_uint4(wv[4], wv[5], wv[6], wv[7]);
    d[2] = make_uint4(wv[8], wv[9], wv[10], wv[11]);
    d[3] = make_uint4(wv[12], wv[13], wv[14], wv[15]);
  }
  __syncthreads();
}

__device__ void phase0(const P& p, char* smem) {
  smem += VHALF * 65536;
  const int tid = VT, lane = tid & 63;
  float* tile = (float*)smem;
  constexpr int NW = 1920, NX = 2064, NR = 513;
  for (int item = VBLK; item < NW + NX + NR; item += VGRD) {
    if (item < NW) {
      wconv_item(p, tile, tid, item < 1568 ? item : item + 1088);
    } else if (item < NW + NX) {
      const int row0 = (item - NW) * 8 + (tid >> 6) * 2;
      float4 v[2][4];
#pragma unroll
      for (int rr = 0; rr < 2; ++rr) {
        const int row = row0 + rr;
        const float* src = row < MP ? p.x_prompt + (size_t)row * D : p.x_sample + (size_t)(row - MP) * D;
#pragma unroll
        for (int i = 0; i < 4; ++i) v[rr][i] = ((const float4*)src)[lane + 64 * i];
      }
#pragma unroll
      for (int rr = 0; rr < 2; ++rr) {
        const int row = row0 + rr;
        u16* xb = (u16*)(p.ws + XB) + (size_t)row * D;
        float ss = 0.f;
#pragma unroll
        for (int i = 0; i < 4; ++i) {
          const float4 q = v[rr][i];
          ss += q.x * q.x + q.y * q.y + q.z * q.z + q.w * q.w;
          ((uint2*)xb)[lane + 64 * i] = make_uint2(pk(q.x, q.y), pk(q.z, q.w));
        }
        ss = wave_sum(ss);
        if (lane < 16) ((float*)(p.ws + SS0))[(size_t)row * 16 + lane] = lane == 0 ? ss : 0.f;
      }
    } else {
      int idx = (item - NW - NX) * 256 + tid;
      if (idx < 2049 * 64) {
        int pi = idx >> 6, i = idx & 63;
        float pos = pi < 2048 ? (float)pi : 16384.f;
        float inv = powf(10000.f, -(float)i / 64.f);
        float ang = pos * inv;
        double a = (double)ang;
        double kq = rint(a * 0.15915494309189535);
        double rr = a - kq * 6.283185307179586;
        float rf = (float)rr;
        ((float*)(p.ws + ROPEC))[idx] = cosf(rf);
        ((float*)(p.ws + ROPES))[idx] = sinf(rf);
      }
    }
  }
}

template <class F>
DEV void load_T(int tid, char* sT, const u16* src, size_t ld, F xf) {
  const int jp = tid & 63, cgp = tid >> 6;
  const u16* s0 = src + (size_t)(2 * jp) * ld + cgp * 32;
  const u16* s1 = s0 + ld;
  const int cb = ((jp >> 2)), bo = (jp & 3) * 4;
#pragma unroll
  for (int h = 0; h < 4; ++h) {
    uint4 a = *(const uint4*)(s0 + h * 8), b = *(const uint4*)(s1 + h * 8);
    float fa[8], fb[8];
    unpack8(a, fa); unpack8(b, fb);
#pragma unroll
    for (int e = 0; e < 8; ++e) {
      int c = cgp * 32 + h * 8 + e;
      *(unsigned*)(sT + toff16(c, cb) + bo) = pk(xf(0, c, fa[e]), xf(1, c, fb[e]));
    }
  }
}
DEV void load_T_ln(int tid, char* sT, const u16* src, size_t ld, float m0, float rs0, float m1, float rs1, const float* vg, const float* vb) {
  const int jp = tid & 63, cgp = tid >> 6;
  const u16* s0 = src + (size_t)(2 * jp) * ld + cgp * 32;
  const u16* s1 = s0 + ld;
  const int cb = ((jp >> 2)), bo = (jp & 3) * 4;
#pragma unroll
  for (int h = 0; h < 4; ++h) {
    uint4 a = *(const uint4*)(s0 + h * 8), b = *(const uint4*)(s1 + h * 8);
    const float4 g0 = *(const float4*)(vg + cgp * 32 + h * 8), g1 = *(const float4*)(vg + cgp * 32 + h * 8 + 4);
    const float4 b0 = *(const float4*)(vb + cgp * 32 + h * 8), b1 = *(const float4*)(vb + cgp * 32 + h * 8 + 4);
    const float gv[8] = {g0.x, g0.y, g0.z, g0.w, g1.x, g1.y, g1.z, g1.w};
    const float bv[8] = {b0.x, b0.y, b0.z, b0.w, b1.x, b1.y, b1.z, b1.w};
    float fa[8], fb[8];
    unpack8(a, fa); unpack8(b, fb);
#pragma unroll
    for (int e = 0; e < 8; ++e) {
      const int c = cgp * 32 + h * 8 + e;
      const float ga = gv[e] * rs0, gb2 = gv[e] * rs1;
      *(unsigned*)(sT + toff16(c, cb) + bo) = pk((fa[e] - m0) * ga + bv[e], (fb[e] - m1) * gb2 + bv[e]);
    }
  }
}
DEV void load_rot(int tid, char* sT, const u16* src, size_t ld, const float* cs, const float* sn, float scale) {
  const int i = tid >> 1, half = tid & 1;
  const u16* s = src + (size_t)i * ld + half * 32;
  const float* c_ = cs + (size_t)i * 64 + half * 32;
  const float* s_ = sn + (size_t)i * 64 + half * 32;
#pragma unroll
  for (int h = 0; h < 4; ++h) {
    uint4 lo = *(const uint4*)(s + h * 8), hi = *(const uint4*)(s + 64 + h * 8);
    float fl[8], fh[8], ol[8], oh[8];
    unpack8(lo, fl); unpack8(hi, fh);
    float4 c0 = *(const float4*)(c_ + h * 8), c1 = *(const float4*)(c_ + h * 8 + 4);
    float4 s0 = *(const float4*)(s_ + h * 8), s1 = *(const float4*)(s_ + h * 8 + 4);
    float cc[8] = {c0.x, c0.y, c0.z, c0.w, c1.x, c1.y, c1.z, c1.w};
    float sv[8] = {s0.x, s0.y, s0.z, s0.w, s1.x, s1.y, s1.z, s1.w};
#pragma unroll
    for (int e = 0; e < 8; ++e) {
      ol[e] = (fl[e] * cc[e] - fh[e] * sv[e]) * scale;
      oh[e] = (fh[e] * cc[e] + fl[e] * sv[e]) * scale;
    }
    *(uint4*)(sT + toff16(i, half * 4 + h)) = pack8(ol);
    *(uint4*)(sT + toff16(i, 8 + half * 4 + h)) = pack8(oh);
  }
}
DEV void load_rot_T(int tid, char* sT, const u16* src, size_t ld, const float* cs, const float* sn) {
  const int jp = tid & 63, w = tid >> 6;
  const u16* s0 = src + (size_t)(2 * jp) * ld + w * 16;
  const u16* s1 = s0 + ld;
  const float* c0p = cs + (size_t)(2 * jp) * 64 + w * 16;
  const float* s0p = sn + (size_t)(2 * jp) * 64 + w * 16;
  const int cb = jp >> 2, bo = (jp & 3) * 4;
#pragma unroll
  for (int h = 0; h < 2; ++h) {
    float fl0[8], fh0[8], fl1[8], fh1[8];
    unpack8(*(const uint4*)(s0 + h * 8), fl0); unpack8(*(const uint4*)(s0 + 64 + h * 8), fh0);
    unpack8(*(const uint4*)(s1 + h * 8), fl1); unpack8(*(const uint4*)(s1 + 64 + h * 8), fh1);
#pragma unroll
    for (int e4 = 0; e4 < 2; ++e4) {
      float4 ca = *(const float4*)(c0p + h * 8 + e4 * 4), sa = *(const float4*)(s0p + h * 8 + e4 * 4);
      float4 cb4 = *(const float4*)(c0p + 64 + h * 8 + e4 * 4), sb4 = *(const float4*)(s0p + 64 + h * 8 + e4 * 4);
      float c0a[4] = {ca.x, ca.y, ca.z, ca.w}, s0a[4] = {sa.x, sa.y, sa.z, sa.w};
      float c1a[4] = {cb4.x, cb4.y, cb4.z, cb4.w}, s1a[4] = {sb4.x, sb4.y, sb4.z, sb4.w};
#pragma unroll
      for (int e = 0; e < 4; ++e) {
        int ee = e4 * 4 + e;
        int d = w * 16 + h * 8 + ee;
        float l0 = fl0[ee] * c0a[e] - fh0[ee] * s0a[e], h0 = fh0[ee] * c0a[e] + fl0[ee] * s0a[e];
        float l1 = fl1[ee] * c1a[e] - fh1[ee] * s1a[e], h1 = fh1[ee] * c1a[e] + fl1[ee] * s1a[e];
        *(unsigned*)(sT + toff16(d, cb) + bo) = pk(l0, l1);
        *(unsigned*)(sT + toff16(d + 64, cb) + bo) = pk(h0, h1);
      }
    }
  }
}
DEV void load_N(int tid, char* sT, const u16* src, size_t ld) {
#pragma unroll
  for (int i = 0; i < 8; ++i) {
    int idx = tid + 256 * i, row = idx >> 4, ch = idx & 15;
    *(uint4*)(sT + toff16(row, ch)) = *(const uint4*)(src + (size_t)row * ld + ch * 8);
  }
}

struct RotTab { float4 c[8], s[8]; };
struct RotDat { uint4 lo[4], hi[4]; };
DEV void rot_tab_issue(RotTab& T, int tid, const float* cs, const float* sn) {
  const int i = tid >> 1, half = tid & 1;
  const float* c_ = cs + (size_t)i * 64 + half * 32;
  const float* s_ = sn + (size_t)i * 64 + half * 32;
#pragma unroll
  for (int h = 0; h < 4; ++h) {
    T.c[2 * h] = *(const float4*)(c_ + h * 8); T.c[2 * h + 1] = *(const float4*)(c_ + h * 8 + 4);
    T.s[2 * h] = *(const float4*)(s_ + h * 8); T.s[2 * h + 1] = *(const float4*)(s_ + h * 8 + 4);
  }
}
DEV void rot_dat_issue(RotDat& R, int tid, const u16* src, size_t ld) {
  const int i = tid >> 1, half = tid & 1;
  const u16* s = src + (size_t)i * ld + half * 32;
#pragma unroll
  for (int h = 0; h < 4; ++h) { R.lo[h] = *(const uint4*)(s + h * 8); R.hi[h] = *(const uint4*)(s + 64 + h * 8); }
}
DEV void rot_commit(const RotDat& R, const RotTab& T, int tid, char* sT, float scale) {
  const int i = tid >> 1, half = tid & 1;
#pragma unroll
  for (int h = 0; h < 4; ++h) {
    float fl[8], fh[8], ol[8], oh[8];
    unpack8(R.lo[h], fl); unpack8(R.hi[h], fh);
    const float4 c0 = T.c[2 * h], c1 = T.c[2 * h + 1], s0 = T.s[2 * h], s1 = T.s[2 * h + 1];
    const float cc[8] = {c0.x, c0.y, c0.z, c0.w, c1.x, c1.y, c1.z, c1.w};
    const float sv[8] = {s0.x, s0.y, s0.z, s0.w, s1.x, s1.y, s1.z, s1.w};
#pragma unroll
    for (int e = 0; e < 8; ++e) {
      ol[e] = (fl[e] * cc[e] - fh[e] * sv[e]) * scale;
      oh[e] = (fh[e] * cc[e] + fl[e] * sv[e]) * scale;
    }
    *(uint4*)(sT + toff16(i, half * 4 + h)) = pack8(ol);
    *(uint4*)(sT + toff16(i, 8 + half * 4 + h)) = pack8(oh);
  }
}
struct TDat { uint4 a[4], b[4]; };
DEV void T_issue(TDat& R, int tid, const u16* src, size_t ld) {
  const int jp = tid & 63, cgp = tid >> 6;
  const u16* s0 = src + (size_t)(2 * jp) * ld + cgp * 32;
  const u16* s1 = s0 + ld;
#pragma unroll
  for (int h = 0; h < 4; ++h) { R.a[h] = *(const uint4*)(s0 + h * 8); R.b[h] = *(const uint4*)(s1 + h * 8); }
}
DEV void T_commit(const TDat& R, int tid, char* sT) {
  const int jp = tid & 63, cgp = tid >> 6;
  const int cb = jp >> 2, bo = (jp & 3) * 4;
#pragma unroll
  for (int h = 0; h < 4; ++h) {
    float fa[8], fb[8];
    unpack8(R.a[h], fa); unpack8(R.b[h], fb);
#pragma unroll
    for (int e = 0; e < 8; ++e) {
      const int c = cgp * 32 + h * 8 + e;
      *(unsigned*)(sT + toff16(c, cb) + bo) = pk(fa[e], fb[e]);
    }
  }
}

__device__ void phase2(const P& p, char* smem) {
  smem += VHALF * 65536;
  const u16* Z = (const u16*)(p.ws + ZB);
  u16* YB = (u16*)(p.ws + YBO);
  const float* cosT = (const float*)(p.ws + ROPEC);
  const float* sinT = (const float*)(p.ws + ROPES);
  float* out = p.out;
  for (int item = VBLK; item < 2048; item += VGRD) {
    int tid = VT;
    asm volatile("" : "+v"(tid));
    const int lane = tid & 63, w = tid >> 6, wm = w >> 1, wn = w & 1, r = lane & 15, q = lane >> 4;
    if (item < 512) {
      const int b = item >> 6, h = (item >> 4) & 3, c = item & 15;
      const size_t R0 = (size_t)b * 2048 + c * 128;
      const float lg = lgh(h);
      char* sV = smem; char* sK = smem + 32768;
      {
        const int jp = tid & 63;
        const float z0 = expf((127.f - 2.f * jp) * lg), z1 = expf((126.f - 2.f * jp) * lg);
        load_T(tid, sV, Z + R0 * 3072 + 1024 + h * 128, 3072, [=](int which, int, float v) { return v * (which ? z1 : z0); });
      }
      load_rot_T(tid, sK, Z + R0 * 3072 + 512 + h * 128, 3072, cosT + (size_t)c * 128 * 64, sinT + (size_t)c * 128 * 64);
      __syncthreads();
      f32x4 acc[4][4];
      zero_acc(acc);
      mma_tile<16>(acc, sV, sK, wm, wn, lane);
      u16* uc = (u16*)(p.ws + UCO) + (size_t)item * 16384;
#pragma unroll
      for (int mi = 0; mi < 4; ++mi)
#pragma unroll
        for (int ni = 0; ni < 4; ++ni) {
          int e = wm * 64 + mi * 16 + r, d = wn * 64 + ni * 16 + q * 4;
          *(uint2*)(uc + e * 128 + d) = make_uint2(pk(acc[mi][ni][0], acc[mi][ni][1]), pk(acc[mi][ni][2], acc[mi][ni][3]));
        }
      __syncthreads();
    } else if (item < 1536) {
      const int it = item - 512, b = it >> 7, c = (it >> 3) & 15, n = it & 7;
      const size_t R0 = (size_t)b * 2048 + c * 128;
      char* sX = smem;
      char* sA = smem + 32768; char* sB = smem + 49152;
      char* sBv = smem + 32768;
      {
        const int t = tid >> 1, half = tid & 1, ch0 = n * 64 + half * 32;
        float xc[32];
#pragma unroll
        for (int k = 0; k < 8; ++k) {
          float4 v = *(const float4*)(p.conv_b + ch0 + k * 4);
          xc[k * 4] = v.x; xc[k * 4 + 1] = v.y; xc[k * 4 + 2] = v.z; xc[k * 4 + 3] = v.w;
        }
#pragma unroll
        for (int j = 0; j < 4; ++j) {
          int tt = c * 128 + t - 3 + j;
          if (tt >= 0) {
            const u16* s = Z + ((size_t)b * 2048 + tt) * 3072 + 2048 + ch0;
            const float* cw = p.conv_w + j * 512 + ch0;
#pragma unroll
            for (int hh = 0; hh < 4; ++hh) {
              float x[8];
              unpack8(*(const uint4*)(s + hh * 8), x);
              float4 w0 = *(const float4*)(cw + hh * 8), w1 = *(const float4*)(cw + hh * 8 + 4);
              xc[hh * 8 + 0] += w0.x * x[0]; xc[hh * 8 + 1] += w0.y * x[1]; xc[hh * 8 + 2] += w0.z * x[2]; xc[hh * 8 + 3] += w0.w * x[3];
              xc[hh * 8 + 4] += w1.x * x[4]; xc[hh * 8 + 5] += w1.y * x[5]; xc[hh * 8 + 6] += w1.z * x[6]; xc[hh * 8 + 7] += w1.w * x[7];
            }
          }
        }
#pragma unroll
        for (int k = 0; k < 8; ++k)
          *(float4*)(sX + xoff(t, half * 32 + k * 4)) = make_float4(xc[k * 4], xc[k * 4 + 1], xc[k * 4 + 2], xc[k * 4 + 3]);
#pragma unroll
        for (int hh = 0; hh < 4; ++hh) *(uint4*)(sA + toff8(t, half * 4 + hh)) = pack8(xc + hh * 8);
      }
      {
        const int d = tid & 63, cgp = tid >> 6;
        const float* wa = p.lru_wa + (size_t)n * 4096 + d;
        const float* wx = p.lru_wx + (size_t)n * 4096 + d;
        float fa[16], fx[16];
#pragma unroll
        for (int k = 0; k < 16; ++k) { fa[k] = wa[(cgp * 16 + k) * 64]; fx[k] = wx[(cgp * 16 + k) * 64]; }
        const int rowA = (d >> 5) * 64 + ((d >> 4) & 1) * 32 + (d & 15), rowX = rowA + 16;
        *(uint4*)(sB + toff8(rowA, cgp * 2)) = pack8(fa);
        *(uint4*)(sB + toff8(rowA, cgp * 2 + 1)) = pack8(fa + 8);
        *(uint4*)(sB + toff8(rowX, cgp * 2)) = pack8(fx);
        *(uint4*)(sB + toff8(rowX, cgp * 2 + 1)) = pack8(fx + 8);
      }
      float bav2[2][4], bxv2[2][4], lav2[2][4];
#pragma unroll
      for (int pp = 0; pp < 2; ++pp) {
        const int chg = n * 64 + wn * 32 + pp * 16 + q * 4;
        const float4 ba = *(const float4*)(p.lru_ba + chg), bx = *(const float4*)(p.lru_bx + chg), lam = *(const float4*)(p.lru_lambda + chg);
        bav2[pp][0] = ba.x; bav2[pp][1] = ba.y; bav2[pp][2] = ba.z; bav2[pp][3] = ba.w;
        bxv2[pp][0] = bx.x; bxv2[pp][1] = bx.y; bxv2[pp][2] = bx.z; bxv2[pp][3] = bx.w;
        lav2[pp][0] = -8.f * log1pf(__expf(-lam.x)); lav2[pp][1] = -8.f * log1pf(__expf(-lam.y));
        lav2[pp][2] = -8.f * log1pf(__expf(-lam.z)); lav2[pp][3] = -8.f * log1pf(__expf(-lam.w));
      }
      __syncthreads();
      f32x4 acc[4][4];
      zero_acc(acc);
      mma_tile<8>(acc, sA, sB, wm, wn, lane);
#pragma unroll
      for (int mi = 0; mi < 4; ++mi)
#pragma unroll
        for (int pp = 0; pp < 2; ++pp) {
          const int t = wm * 64 + mi * 16 + r, chl = wn * 32 + pp * 16 + q * 4;
          float4 xv = *(const float4*)(sX + xoff(t, chl));
          const float* bav = bav2[pp]; const float* bxv = bxv2[pp]; const float* lav = lav2[pp];
          float xvv[4] = {xv.x, xv.y, xv.z, xv.w};
#pragma unroll
          for (int j = 0; j < 4; ++j) {
            float rr = sigmoidf_(acc[mi][2 * pp][j] + bav[j]);
            float ii = sigmoidf_(acc[mi][2 * pp + 1][j] + bxv[j]);
            float la = rr * lav[j];
            float a = __expf(la);
            float mult = sqrtf(fmaxf(1.f - a * a, 0.f));
            acc[mi][2 * pp][j] = a;
            acc[mi][2 * pp + 1][j] = xvv[j] * ii * mult;
          }
        }
      __syncthreads();
#pragma unroll
      for (int mi = 0; mi < 4; ++mi)
#pragma unroll
        for (int pp = 0; pp < 2; ++pp) {
          const int t = wm * 64 + mi * 16 + r, chl = wn * 32 + pp * 16 + q * 4;
          *(f32x4*)(sX + xoff(t, chl)) = acc[mi][2 * pp];
          *(f32x4*)(sBv + xoff(t, chl)) = acc[mi][2 * pp + 1];
        }
      __syncthreads();
      {
        const int ch = lane, t0 = w * 32;
        float hl_[32], pl_[32];
        float hh = 0.f, pq = 1.f;
#pragma unroll
        for (int t = 0; t < 32; ++t) {
          const float a = *(const float*)(sX + xoff(t0 + t, ch)), bb = *(const float*)(sBv + xoff(t0 + t, ch));
          hh = a * hh + bb;
          pq *= a;
          hl_[t] = hh; pl_[t] = pq;
        }
        __syncthreads();
        float* carry = (float*)sX;
        carry[(w * 2 + 0) * 64 + ch] = pq;
        carry[(w * 2 + 1) * 64 + ch] = hh;
        __syncthreads();
        float hin = 0.f, pin = 1.f;
#pragma unroll
        for (int ww = 0; ww < 3; ++ww) {
          if (ww < w) {
            const float pw = carry[(ww * 2 + 0) * 64 + ch], hw = carry[(ww * 2 + 1) * 64 + ch];
            hin = pw * hin + hw;
            pin *= pw;
          }
        }
        u16* hl = (u16*)out + (R0 + t0) * 512 + n * 64 + ch;
        u16* pl = (u16*)out + 8388608 + (R0 + t0) * 512 + n * 64 + ch;
#pragma unroll
        for (int t = 0; t < 32; ++t) {
          hl[(size_t)t * 512] = f2bf(hl_[t] + pl_[t] * hin);
          pl[(size_t)t * 512] = f2bf(pl_[t] * pin);
        }
        if (w == 3) {
          ((float*)(p.ws + AGGP))[(b * 16 + c) * 512 + n * 64 + ch] = pl_[31] * pin;
          ((float*)(p.ws + AGGH))[(b * 16 + c) * 512 + n * 64 + ch] = hl_[31] + pl_[31] * hin;
        }
      }
      __syncthreads();
    } else {
      const int it = item - 1536, b = it >> 2, h = it & 3;
      const size_t row = MP + b;
      float* sq = (float*)smem; float* sk = sq + 128; float* sv = sq + 256; float* red = sq + 384;
      float4 s0v[16];
      {
        const float* S0p = p.state_ret + ((size_t)(b * 4 + h) * 128) * 128 + (tid >> 5) * 16 * 128 + (tid & 31) * 4;
#pragma unroll
        for (int dd = 0; dd < 16; ++dd) s0v[dd] = *(const float4*)(S0p + dd * 128);
      }
      if (tid < 128) {
        const int d = tid, dl = d & 63;
        const float cc = cosT[2048 * 64 + dl], sn = sinT[2048 * 64 + dl];
        const u16* zr = Z + row * 3072 + h * 128;
        float q1 = bf(zr[dl]), q2 = bf(zr[dl + 64]), k1 = bf(zr[512 + dl]), k2 = bf(zr[512 + dl + 64]);
        float qo = d < 64 ? q1 * cc - q2 * sn : q2 * cc + q1 * sn;
        float ko = d < 64 ? k1 * cc - k2 * sn : k2 * cc + k1 * sn;
        sq[d] = qo * 0.08838834764831845f; sk[d] = ko; sv[d] = bf(zr[1024 + d]);
      }
      __syncthreads();
      {
        const float gamma = 1.f - exp2f(-5.f - (float)h);
        const int e4 = tid & 31, dg = tid >> 5;
        const size_t so = ((size_t)(b * 4 + h) * 128) * 128;
        const float* S0 = p.state_ret + so;
        float* Sn = out + O_RETS + so;
        const float4 v4 = *(const float4*)(sv + e4 * 4);
        float4 o = make_float4(0.f, 0.f, 0.f, 0.f);
#pragma unroll
        for (int dd = 0; dd < 16; ++dd) {
          const int d = dg * 16 + dd;
          const float4 s0 = s0v[dd];
          const float kd = sk[d], qd = sq[d];
          float4 s1;
          s1.x = gamma * s0.x + kd * v4.x; s1.y = gamma * s0.y + kd * v4.y; s1.z = gamma * s0.z + kd * v4.z; s1.w = gamma * s0.w + kd * v4.w;
          *(float4*)(Sn + d * 128 + e4 * 4) = s1;
          o.x += qd * s1.x; o.y += qd * s1.y; o.z += qd * s1.z; o.w += qd * s1.w;
        }
        *(float4*)(red + dg * 128 + e4 * 4) = o;
      }
      __syncthreads();
      if (tid < 64) {
        float o1 = 0.f, o2 = 0.f;
#pragma unroll
        for (int dg = 0; dg < 8; ++dg) { o1 += red[dg * 128 + tid]; o2 += red[dg * 128 + 64 + tid]; }
        const float mean = wave_sum(o1 + o2) * (1.f / 128.f);
        const float d1 = o1 - mean, d2 = o2 - mean;
        const float var = wave_sum(d1 * d1 + d2 * d2) * (1.f / 128.f);
        const float rs = rsqrtf(var + EPS);
        const u16* zg = Z + row * 3072 + 1536 + h * 128;
        const float g1 = bf(zg[tid]), g2 = bf(zg[tid + 64]);
        YB[row * 1024 + h * 128 + tid] = f2bf(d1 * rs * p.ret_gn[h * 128 + tid] * siluf_(g1));
        YB[row * 1024 + h * 128 + 64 + tid] = f2bf(d2 * rs * p.ret_gn[h * 128 + 64 + tid] * siluf_(g2));
      }
      __syncthreads();
      if (h < 2) {
        float* xs = (float*)(smem + 8192);
        const int ch = h * 256 + tid;
        {
          const float x = bf(Z[row * 3072 + 2048 + ch]);
          const float b0 = p.state_conv[(b * 3 + 0) * 512 + ch], b1 = p.state_conv[(b * 3 + 1) * 512 + ch], b2 = p.state_conv[(b * 3 + 2) * 512 + ch];
          xs[tid] = p.conv_b[ch] + p.conv_w[ch] * b0 + p.conv_w[512 + ch] * b1 + p.conv_w[1024 + ch] * b2 + p.conv_w[1536 + ch] * x;
          out[O_CONVS + (b * 3 + 0) * 512 + ch] = b1;
          out[O_CONVS + (b * 3 + 1) * 512 + ch] = b2;
          out[O_CONVS + (b * 3 + 2) * 512 + ch] = x;
        }
        __syncthreads();
        {
          const int n = ch >> 6, d = ch & 63;
          float racc = p.lru_ba[ch], iacc = p.lru_bx[ch];
          const float* wa = p.lru_wa + (size_t)n * 4096 + d;
          const float* wx = p.lru_wx + (size_t)n * 4096 + d;
#pragma unroll 16
          for (int cc = 0; cc < 64; ++cc) {
            const float xv = xs[(n & 3) * 64 + cc];
            racc += xv * wa[cc * 64];
            iacc += xv * wx[cc * 64];
          }
          const float rr = sigmoidf_(racc), ii = sigmoidf_(iacc);
          const float la = -8.f * rr * log1pf(expf(-p.lru_lambda[ch]));
          const float a = expf(la), mult = sqrtf(-expm1f(2.f * la));
          const float hv = a * p.state_lru[b * 512 + ch] + mult * ii * xs[tid];
          out[O_LRUS + b * 512 + ch] = hv;
          const float gb = bf(Z[row * 3072 + 2560 + ch]);
          YB[row * 1024 + 512 + ch] = f2bf(hv * geluf_(gb));
        }
        __syncthreads();
      }
    }
  }
  for (int idx = blockIdx.x * blockDim.x + threadIdx.x; idx < 12288; idx += gridDim.x * blockDim.x) {
    const int b = idx / 1536, j = (idx / 512) % 3, ch = idx & 511;
    out[O_CONVP + idx] = bf(Z[((size_t)b * 2048 + 2045 + j) * 3072 + 2048 + ch]);
  }
}

__device__ void phase3(const P& p) {
  const int gt = blockIdx.x * blockDim.x + threadIdx.x, gn = gridDim.x * blockDim.x;
  const u16* Z = (const u16*)(p.ws + ZB);
  u16* YB = (u16*)(p.ws + YBO);
  float* out = p.out;
  {
    const u16* UC = (const u16*)(p.ws + UCO);
    u16* SST = (u16*)(p.ws + SSTO);
    for (int v = gt; v < 131072; v += gn) {
      const int bh = v >> 12, idx4 = (v & 4095) * 4, e = idx4 >> 7, d = idx4 & 127;
      const float g128 = expf(128.f * lgh(bh & 3));
      float4 s = make_float4(0.f, 0.f, 0.f, 0.f);
      uint2 uu[16];
#pragma unroll
      for (int c = 0; c < 16; ++c) uu[c] = *(const uint2*)(UC + ((size_t)(bh * 16 + c)) * 16384 + idx4);
#pragma unroll
      for (int c = 0; c < 16; ++c) {
        const size_t o = ((size_t)(bh * 16 + c)) * 16384 + idx4;
        *(uint2*)(SST + o) = make_uint2(pk(s.x, s.y), pk(s.z, s.w));
        const float4 u = make_float4(blo(uu[c].x), bhi(uu[c].x), blo(uu[c].y), bhi(uu[c].y));
        s.x = g128 * s.x + u.x; s.y = g128 * s.y + u.y; s.z = g128 * s.z + u.z; s.w = g128 * s.w + u.w;
      }
      float* o = out + O_RETP + ((size_t)bh * 128 + d) * 128 + e;
      o[0] = s.x; o[128] = s.y; o[256] = s.z; o[384] = s.w;
    }
  }
  {
    const float* aggP = (const float*)(p.ws + AGGP);
    const float* aggH = (const float*)(p.ws + AGGH);
    for (int v = gt; v < 131072; v += gn) {
      const int ch = (v & 127) * 4, rg = (v >> 7) & 7, c = (v >> 10) & 15, b = v >> 14;
      float4 hs = make_float4(0.f, 0.f, 0.f, 0.f);
#pragma unroll
      for (int cc = 0; cc < 15; ++cc) {
        if (cc < c) {
          float4 pp = *(const float4*)(aggP + (b * 16 + cc) * 512 + ch), hh = *(const float4*)(aggH + (b * 16 + cc) * 512 + ch);
          hs.x = pp.x * hs.x + hh.x; hs.y = pp.y * hs.y + hh.y; hs.z = pp.z * hs.z + hh.z; hs.w = pp.w * hs.w + hh.w;
        }
      }
      const int row0 = b * 2048 + c * 128 + rg * 16;
#pragma unroll 8
      for (int i = 0; i < 16; ++i) {
        const int row = row0 + i;
        const uint2 hl2 = *(const uint2*)((const u16*)out + (size_t)row * 512 + ch), pq2 = *(const uint2*)((const u16*)out + 8388608 + (size_t)row * 512 + ch);
        const float4 hl = make_float4(blo(hl2.x), bhi(hl2.x), blo(hl2.y), bhi(hl2.y)), pq = make_float4(blo(pq2.x), bhi(pq2.x), blo(pq2.y), bhi(pq2.y));
        float4 hv;
        hv.x = hl.x + pq.x * hs.x; hv.y = hl.y + pq.y * hs.y; hv.z = hl.z + pq.z * hs.z; hv.w = hl.w + pq.w * hs.w;
        uint2 g = *(const uint2*)(Z + (size_t)row * 3072 + 2560 + ch);
        *(uint2*)(YB + (size_t)row * 1024 + 512 + ch) =
            make_uint2(pk(hv.x * geluf_(blo(g.x)), hv.y * geluf_(bhi(g.x))), pk(hv.z * geluf_(blo(g.y)), hv.w * geluf_(bhi(g.y))));
        if ((row & 2047) == 2047) *(float4*)(out + O_LRUP + b * 512 + ch) = hv;
      }
    }
  }
}

__device__ void phase4(const P& p, char* smem) {
  smem += VHALF * 65536;
  const u16* Z = (const u16*)(p.ws + ZB);
  u16* YB = (u16*)(p.ws + YBO);
  const u16* SST = (const u16*)(p.ws + SSTO);
  const float* cosT = (const float*)(p.ws + ROPEC);
  const float* sinT = (const float*)(p.ws + ROPES);
  char* bufA = smem; char* bufB = smem + 32768;
  for (int item = VBLK; item < 512; item += VGRD) {
    int tid = VT;
    asm volatile("" : "+v"(tid));
    const int lane = tid & 63, w = tid >> 6, wm = w >> 1, wn = w & 1, r = lane & 15, q = lane >> 4;
    const int b = item >> 6, h = (item >> 4) & 3, c = item & 15;
    const size_t R0 = (size_t)b * 2048 + c * 128;
    const float lg = lgh(h);
    const float* cs = cosT + (size_t)c * 128 * 64;
    const float* sn = sinT + (size_t)c * 128 * 64;
    RotTab T;
    RotDat qd, kd;
    rot_tab_issue(T, tid, cs, sn);
    rot_dat_issue(qd, tid, Z + R0 * 3072 + h * 128, 3072);
    load_N(tid, bufB, SST + (size_t)item * 16384, 128);
    rot_commit(qd, T, tid, bufA, 0.08838834764831845f);
    rot_dat_issue(kd, tid, Z + R0 * 3072 + 512 + h * 128, 3072);
    __syncthreads();
    f32x4 acco[4][4];
    zero_acc(acco);
    mma_tile<16>(acco, bufA, bufB, wm, wn, lane);
#pragma unroll
    for (int mi = 0; mi < 4; ++mi) {
      const float xi = expf((float)(wm * 64 + mi * 16 + r + 1) * lg);
#pragma unroll
      for (int ni = 0; ni < 4; ++ni) acco[mi][ni] *= xi;
    }
    __syncthreads();
    rot_commit(kd, T, tid, bufB, 1.f);
    TDat vd;
    T_issue(vd, tid, Z + R0 * 3072 + 1024 + h * 128, 3072);
    __syncthreads();
    f32x4 accs[4][4];
    zero_acc(accs);
    mma_tile<16>(accs, bufA, bufB, wm, wn, lane);
    __syncthreads();
#pragma unroll
    for (int mi = 0; mi < 4; ++mi)
#pragma unroll
      for (int ni = 0; ni < 4; ++ni) {
        const int i = wm * 64 + mi * 16 + r, j0 = wn * 64 + ni * 16 + q * 4;
        float o[4];
#pragma unroll
        for (int j = 0; j < 4; ++j) {
          const int df = i - (j0 + j);
          o[j] = df >= 0 ? accs[mi][ni][j] * __expf((float)df * lg) : 0.f;
        }
        *(uint2*)(bufA + toff16(i, j0 >> 3) + (j0 & 7) * 2) = make_uint2(pk(o[0], o[1]), pk(o[2], o[3]));
      }
    T_commit(vd, tid, bufB);
    const int gi = tid >> 1, ghalf = tid & 1;
    const u16* zg = Z + (R0 + gi) * 3072 + 1536 + h * 128 + ghalf * 64;
    const float* gn = p.ret_gn + h * 128 + ghalf * 64;
    uint4 gq[8];
    float4 gn0[8], gn1[8];
#pragma unroll
    for (int k = 0; k < 8; ++k) { gq[k] = *(const uint4*)(zg + k * 8); gn0[k] = *(const float4*)(gn + k * 8); gn1[k] = *(const float4*)(gn + k * 8 + 4); }
    __syncthreads();
    mma_tile<16>(acco, bufA, bufB, wm, wn, lane);
    __syncthreads();
#pragma unroll
    for (int mi = 0; mi < 4; ++mi)
#pragma unroll
      for (int ni = 0; ni < 4; ++ni) {
        const int i = wm * 64 + mi * 16 + r, e = wn * 64 + ni * 16 + q * 4;
        *(f32x4*)(smem + ooff(i, e)) = acco[mi][ni];
      }
    __syncthreads();
    {
      const int i = gi, half = ghalf;
      float x[64];
      float s = 0.f;
#pragma unroll
      for (int k = 0; k < 16; ++k) {
        float4 v = *(const float4*)(smem + ooff(i, half * 64 + k * 4));
        x[k * 4] = v.x; x[k * 4 + 1] = v.y; x[k * 4 + 2] = v.z; x[k * 4 + 3] = v.w;
        s += v.x + v.y + v.z + v.w;
      }
      s += __shfl_xor(s, 1);
      const float mean = s * (1.f / 128.f);
      float vs = 0.f;
#pragma unroll
      for (int k = 0; k < 64; ++k) { x[k] -= mean; vs += x[k] * x[k]; }
      vs += __shfl_xor(vs, 1);
      const float rs = rsqrtf(vs * (1.f / 128.f) + EPS);
      u16* yo = YB + (R0 + i) * 1024 + h * 128 + half * 64;
#pragma unroll
      for (int k = 0; k < 8; ++k) {
        float g[8], o[8];
        unpack8(gq[k], g);
        const float4 g0 = gn0[k], g1 = gn1[k];
        float gv[8] = {g0.x, g0.y, g0.z, g0.w, g1.x, g1.y, g1.z, g1.w};
#pragma unroll
        for (int e = 0; e < 8; ++e) o[e] = x[k * 8 + e] * rs * gv[e] * siluf_(g[e]);
        *(uint4*)(yo + k * 8) = pack8(o);
      }
    }
    __syncthreads();
  }
}

__device__ void phase9(const P& p, char* smem) {
  smem += VHALF * 65536;
  const u16* UB = (const u16*)(p.ws + ZB);
  const u16* VB = (const u16*)(p.ws + ZB + 33816576);
  u16* YB = (u16*)(p.ws + YBO);
  const float* lns = (const float*)(p.ws + LNSO);
  const float* lnq = (const float*)(p.ws + LNQO);
  char* bufA = smem; char* bufB = smem + 32768;
  for (int item = VBLK; item < 1024 + 32; item += VGRD) {
    int tid = VT;
    asm volatile("" : "+v"(tid));
    const int lane = tid & 63, w = tid >> 6, wm = w >> 1, wn = w & 1, r = lane & 15, q = lane >> 4;
    if (item < 1024) {
      const int b = item >> 7, c = (item >> 3) & 15, g = item & 7;
      const size_t R0 = (size_t)b * 2048 + c * 128;
#pragma unroll
      for (int i = 0; i < 8; ++i) {
        int idx = tid + 256 * i, row = idx >> 4, ch = idx & 15;
        const float* s = p.sg_ws + ((size_t)(g * 128 + row)) * 128 + ch * 8;
        float4 a = *(const float4*)s, bq = *(const float4*)(s + 4);
        float f[8] = {a.x, a.y, a.z, a.w, bq.x, bq.y, bq.z, bq.w};
#pragma unroll
        for (int e = 0; e < 8; ++e) f[e] = (ch * 8 + e <= row) ? f[e] : 0.f;
        *(uint4*)(bufA + toff16(row, ch)) = pack8(f);
      }
      {
        const int jp = tid & 63;
        const int r0 = (int)R0 + 2 * jp;
        const float m0 = sum16(lns, r0) * (1.f / 1024.f), m1 = sum16(lns, r0 + 1) * (1.f / 1024.f);
        const float v0 = sum16(lnq, r0) * (1.f / 1024.f) - m0 * m0, v1 = sum16(lnq, r0 + 1) * (1.f / 1024.f) - m1 * m1;
        const float rs0 = rsqrtf(fmaxf(v0, 0.f) + EPS), rs1 = rsqrtf(fmaxf(v1, 0.f) + EPS);
        const float* vg = p.sg_norm_g + g * 128; const float* vb = p.sg_norm_b + g * 128;
        load_T_ln(tid, bufB, VB + R0 * 1024 + g * 128, 1024, m0, rs0, m1, rs1, vg, vb);
      }
      uint2 uu[4][4];
      float bsv[4];
#pragma unroll
      for (int mi = 0; mi < 4; ++mi) {
        const int i = wm * 64 + mi * 16 + r;
        bsv[mi] = p.sg_bs[g * 128 + i];
#pragma unroll
        for (int ni = 0; ni < 4; ++ni) uu[mi][ni] = *(const uint2*)(UB + (R0 + i) * 1024 + g * 128 + wn * 64 + ni * 16 + q * 4);
      }
      __syncthreads();
      f32x4 acc[4][4];
      zero_acc(acc);
      mma_tile<16>(acc, bufA, bufB, wm, wn, lane);
#pragma unroll
      for (int mi = 0; mi < 4; ++mi) {
        const int i = wm * 64 + mi * 16 + r;
        const float bs = bsv[mi];
#pragma unroll
        for (int ni = 0; ni < 4; ++ni) {
          const size_t o = (R0 + i) * 1024 + g * 128 + wn * 64 + ni * 16 + q * 4;
          const uint2 u = uu[mi][ni];
          f32x4 a = acc[mi][ni];
          *(uint2*)(YB + o) = make_uint2(pk(blo(u.x) * (a[0] + bs), bhi(u.x) * (a[1] + bs)), pk(blo(u.y) * (a[2] + bs), bhi(u.y) * (a[3] + bs)));
        }
      }
      __syncthreads();
    } else {
      const int row = MP + (item - 1024) * 4 + w;
      const float m = sum16(lns, row) * (1.f / 1024.f);
      const float var = sum16(lnq, row) * (1.f / 1024.f) - m * m;
      const float rs = rsqrtf(fmaxf(var, 0.f) + EPS);
#pragma unroll
      for (int i = 0; i < 4; ++i) {
        const int ch = (lane + 64 * i) * 4, g = ch >> 7;
        uint2 vv = *(const uint2*)(VB + (size_t)row * 1024 + ch), uu = *(const uint2*)(UB + (size_t)row * 1024 + ch);
        float4 gg = *(const float4*)(p.sg_norm_g + ch), bb = *(const float4*)(p.sg_norm_b + ch);
        float4 vn;
        vn.x = (blo(vv.x) - m) * rs * gg.x + bb.x; vn.y = (bhi(vv.x) - m) * rs * gg.y + bb.y;
        vn.z = (blo(vv.y) - m) * rs * gg.z + bb.z; vn.w = (bhi(vv.y) - m) * rs * gg.w + bb.w;
        *(float4*)(p.out + O_SGUV + (size_t)(row - MP) * 1024 + ch) = vn;
        const float w00 = p.sg_ws[(size_t)g * 16384], b0 = p.sg_bs[g * 128];
        *(uint2*)(YB + (size_t)row * 1024 + ch) =
            make_uint2(pk(blo(uu.x) * (w00 * vn.x + b0), bhi(uu.x) * (w00 * vn.y + b0)), pk(blo(uu.y) * (w00 * vn.z + b0), bhi(uu.y) * (w00 * vn.w + b0)));
      }
    }
  }
}

__device__ void phase13(const P& p) {
  const int lane = tidx_() & 63, w = VT >> 6;
  const u16* xb = (const u16*)(p.ws + XB);
  for (int item = VBLK; item < 2064; item += VGRD) {
    const int row0 = item * 8 + w * 2;
    uint4 v[2][2];
#pragma unroll
    for (int rr = 0; rr < 2; ++rr)
#pragma unroll
      for (int i = 0; i < 2; ++i) v[rr][i] = *(const uint4*)(xb + (size_t)(row0 + rr) * D + (lane + 64 * i) * 8);
#pragma unroll
    for (int rr = 0; rr < 2; ++rr) {
      float f[2][8];
      float ss = 0.f;
#pragma unroll
      for (int i = 0; i < 2; ++i) {
        unpack8(v[rr][i], f[i]);
#pragma unroll
        for (int j = 0; j < 8; ++j) ss += f[i][j] * f[i][j];
      }
      ss = wave_sum(ss);
      const float rs = rsqrtf(ss * (1.f / 1024.f) + EPS);
      float* y = p.out + (size_t)(row0 + rr) * D;
#pragma unroll
      for (int i = 0; i < 2; ++i) {
        const int c0 = (lane + 64 * i) * 8;
        const float4 g0 = *(const float4*)(p.norm_f + c0), g1 = *(const float4*)(p.norm_f + c0 + 4);
        *(float4*)(y + c0) = make_float4(f[i][0] * rs * g0.x, f[i][1] * rs * g0.y, f[i][2] * rs * g0.z, f[i][3] * rs * g0.w);
        *(float4*)(y + c0 + 4) = make_float4(f[i][4] * rs * g1.x, f[i][5] * rs * g1.y, f[i][6] * rs * g1.z, f[i][7] * rs * g1.w);
      }
    }
  }
}

template <int PH>
DEV void run_phase(const P& p, char* smem, int vx = -1, int vl = 0) {
  char* ws = p.ws;
  GArgs g{};
  g.resid = p.out;
  if (PH == 0) phase0(p, smem);
  else if (PH == 1) {
    g.A = (const u16*)(ws + XB); g.lda = 1024; g.B = (const u16*)(ws + W_INA); g.K = 1024; g.ntn = 24; g.PM = 8;
    g.ss = (const float*)(ws + SS0); g.o16 = (u16*)(ws + ZB);
    gemm_phase<EPI_INA>(p, g, smem);
  } else if (PH == 2) phase2(p, smem);
  else if (PH == 3) phase3(p);
  else if (PH == 4) phase4(p, smem);
  else if (PH == 5) {
    g.A = (const u16*)(ws + YBO); g.lda = 1024; g.B = (const u16*)(ws + W_OUTA); g.K = 1024; g.ntn = 8; g.PM = 8;
    g.ssw = (float*)(ws + SS0 + SSSZ); g.o16 = (u16*)(ws + XB);
    g.skip_sample = 1;
    gemm_phase<EPI_RES>(p, g, smem);
  } else if (PH == 6) {
    g.A = (const u16*)(ws + XB); g.lda = 1024; g.B = (const u16*)(ws + W_GU0); g.K = 1024; g.ntn = 44; g.PM = 16;
    g.ss = (const float*)(ws + SS0 + SSSZ); g.o16 = (u16*)(ws + ZB);
    GArgs g2{};
    g2.resid = p.out;
    g2.A = (const u16*)(ws + ZB); g2.lda = 2816; g2.B = (const u16*)(ws + W_D0); g2.K = 2816; g2.ntn = 8; g2.PM = 8;
    g2.ssw = (float*)(ws + SS0 + 2 * SSSZ); g2.o16 = (u16*)(ws + XB);
    GArgs g0{};
    g0.resid = p.out;
    g0.A = (const u16*)(ws + YBO); g0.lda = 1024; g0.B = (const u16*)(ws + W_OUTA); g0.K = 1024; g0.ntn = 8; g0.PM = 8;
    g0.ssw = (float*)(ws + SS0 + SSSZ); g0.o16 = (u16*)(ws + XB);
    g.prev = &g0; g.prev_in = 0;
    g.next = &g2; g.cnt = (unsigned*)(ws + BARO) + 32;
    g.wc_lo = 1568; g.wc_hi = 2656;
    gemm_phase<EPI_GU>(p, g, smem);
  } else if (PH == 7) {
    g.A = (const u16*)(ws + ZB); g.lda = 2816; g.B = (const u16*)(ws + W_D0); g.K = 2816; g.ntn = 8; g.PM = 8;
    g.ssw = (float*)(ws + SS0 + 2 * SSSZ); g.o16 = (u16*)(ws + XB); g.skip_sample = 1;
    gemm_phase<EPI_RES>(p, g, smem);
  } else if (PH == 8) {
    g.A = (const u16*)(ws + XB); g.lda = 1024; g.B = (const u16*)(ws + W_INC); g.K = 1024; g.ntn = 16; g.PM = 8;
    g.ss = (const float*)(ws + SS0 + 2 * SSSZ); g.o16 = (u16*)(ws + ZB); g.o16b = (u16*)(ws + ZB + 33816576);
    g.lns = (float*)(ws + LNSO); g.lnq = (float*)(ws + LNQO);
    gemm_phase<EPI_INC>(p, g, smem);
  } else if (PH == 9) phase9(p, smem);
  else if (PH == 10) {
    g.A = (const u16*)(ws + YBO); g.lda = 1024; g.B = (const u16*)(ws + W_OUTC); g.K = 1024; g.ntn = 8; g.PM = 8;
    g.ssw = (float*)(ws + SS0 + 3 * SSSZ); g.o16 = (u16*)(ws + XB);
    g.skip_sample = 1;
    gemm_phase<EPI_RES>(p, g, smem);
  } else if (PH == 11) {
    g.A = (const u16*)(ws + XB); g.lda = 1024; g.B = (const u16*)(ws + W_GU1); g.K = 1024; g.ntn = 44; g.PM = 16;
    g.ss = (const float*)(ws + SS0 + 3 * SSSZ); g.o16 = (u16*)(ws + ZB);
    GArgs g2{};
    g2.resid = p.out;
    g2.A = (const u16*)(ws + ZB); g2.lda = 2816; g2.B = (const u16*)(ws + W_D1); g2.K = 2816; g2.ntn = 8; g2.PM = 8;
    g2.ssw = (float*)(ws + SS0 + 4 * SSSZ); g2.o16 = (u16*)(ws + XB);
    GArgs g0{};
    g0.resid = p.out;
    g0.A = (const u16*)(ws + YBO); g0.lda = 1024; g0.B = (const u16*)(ws + W_OUTC); g0.K = 1024; g0.ntn = 8; g0.PM = 8;
    g0.ssw = (float*)(ws + SS0 + 3 * SSSZ); g0.o16 = (u16*)(ws + XB);
    g.prev = &g0; g.prev_in = 0;
    g.next = &g2; g.cnt = (unsigned*)(ws + BARO) + 64;
    g.wc_lo = 0; g.wc_hi = 0;
    gemm_phase<EPI_GU>(p, g, smem);
  } else if (PH == 12) {
    g.A = (const u16*)(ws + ZB); g.lda = 2816; g.B = (const u16*)(ws + W_D1); g.K = 2816; g.ntn = 8; g.PM = 8;
    g.ssw = (float*)(ws + SS0 + 4 * SSSZ); g.o16 = (u16*)(ws + XB); g.skip_sample = 1;
    gemm_phase<EPI_RES>(p, g, smem);
  } else if (PH == 13) phase13(p);
}

#if FUSED
#define XB_TMO      128
#define XB_XCNT(j)  (256  + 64 * (j))
#define XB_XSUB(j)  (1280 + 64 * (j))
#define XB_XGEN(j)  (2304 + 64 * (j))
#define XB_TOP      3328
#define XB_TOPGEN   3392
#define XCD_BAR_WORDS 3456
#define XB_SPIN_CAP (1u << 22)
DEV unsigned xb_ld(unsigned* p) { return __hip_atomic_load(p, __ATOMIC_RELAXED, __HIP_MEMORY_SCOPE_AGENT); }
DEV unsigned xb_add(unsigned* p, unsigned v) { return __hip_atomic_fetch_add(p, v, __ATOMIC_RELAXED, __HIP_MEMORY_SCOPE_AGENT); }
DEV unsigned xb_xcc_id() { return (unsigned)__builtin_amdgcn_s_getreg((3 << 11) | 20) & 0xFu; }
#define XB_SPIN(cond, bar) do { unsigned _sp = 0; while (cond) { __builtin_amdgcn_s_sleep(1); \
    if ((++_sp & 255u) == 0u) { if (xb_ld(&(bar)[XB_TMO])) break; if (_sp > XB_SPIN_CAP) { atomicAdd(&(bar)[XB_TMO], 1u); break; } } } } while (0)
DEV void xb_complete(unsigned* bar, unsigned x, unsigned& nloc, unsigned& nx, unsigned& even) {
  const unsigned G = gridDim.x;
  unsigned sum, cnt, mine, sp = 0u;
  for (;;) {
    sum = 0u; cnt = 0u; mine = 0u; even = 1u;
#pragma unroll
    for (unsigned j = 0; j < 16; ++j) { const unsigned c = xb_ld(&bar[XB_XCNT(j)]); sum += c; cnt += (c > 0u) ? 1u : 0u; mine = (j == x) ? c : mine;
      if (j < 8 ? (c * 8u != G) : (c != 0u)) even = 0u; }
    if (sum == G) break;
    __builtin_amdgcn_s_sleep(1);
    if ((++sp & 255u) == 0u) { if (xb_ld(&bar[XB_TMO])) break; if (sp > XB_SPIN_CAP) { atomicAdd(&bar[XB_TMO], 1u); break; } }
  }
  nloc = mine > 0u ? mine : 1u; nx = cnt > 0u ? cnt : 1u;
}
DEV void gbar(unsigned* bar, unsigned x, unsigned& nloc, unsigned& nx, unsigned* evenp = nullptr) {
  asm volatile("s_waitcnt vmcnt(0)" ::: "memory");
  __syncthreads();
  if (threadIdx.x == 0) {
    __builtin_amdgcn_s_waitcnt(0);
    if (nloc == 0u) { unsigned ev; xb_complete(bar, x, nloc, nx, ev); if (evenp) *evenp = ev; }
    const unsigned old = xb_add(&bar[XB_XSUB(x)], 1u);
    const unsigned gen = old / nloc;
    if (old + 1u == (gen + 1u) * nloc) {
      __builtin_amdgcn_fence(__ATOMIC_RELEASE, "agent");
      asm volatile("s_waitcnt vmcnt(0)" ::: "memory");
      const unsigned og = xb_add(&bar[XB_TOP], 1u);
      const unsigned tg = og / nx;
      if (og + 1u == (tg + 1u) * nx) xb_add(&bar[XB_TOPGEN], 1u);
      else XB_SPIN(xb_ld(&bar[XB_TOPGEN]) == tg, bar);
      __builtin_amdgcn_fence(__ATOMIC_ACQUIRE, "agent");
      xb_add(&bar[XB_XGEN(x)], 1u);
      asm volatile("s_waitcnt vmcnt(0)" ::: "memory");
    } else {
      XB_SPIN(xb_ld(&bar[XB_XGEN(x)]) == gen, bar);
      __builtin_amdgcn_fence(__ATOMIC_ACQUIRE, "agent");
      asm volatile("s_waitcnt vmcnt(0)" ::: "memory");
    }
  }
  __syncthreads();
}
__global__ void __launch_bounds__(512, 2) mega(P p) {
  extern __shared__ __attribute__((aligned(16))) char smem[];
  cg::grid_group grid = cg::this_grid();
  unsigned* bar = (unsigned*)(p.ws + BARO);
  const unsigned xcc = xb_xcc_id();
  unsigned nloc = 0u, nx = 0u;
  if (threadIdx.x == 0) ((unsigned*)smem)[32767] = xb_add(&bar[XB_XCNT(xcc)], 1u);
  if (p.ws == nullptr) grid.sync();
  __syncthreads();
  const int rank = (int)((unsigned*)smem)[32767];
  __syncthreads();
  run_phase<0>(p, smem);
  gbar(bar, xcc, nloc, nx, (unsigned*)smem + 32766);
  const bool even = ((unsigned*)smem)[32766] != 0u;
  __syncthreads();
  const int vx = even ? (int)xcc : -1, vl = rank;
  run_phase<1>(p, smem, vx, vl); gbar(bar, xcc, nloc, nx);
  run_phase<2>(p, smem); gbar(bar, xcc, nloc, nx);
  run_phase<3>(p, smem); gbar(bar, xcc, nloc, nx);
  run_phase<4>(p, smem); gbar(bar, xcc, nloc, nx);
  run_phase<5>(p, smem, vx, vl); gbar(bar, xcc, nloc, nx);
  run_phase<6>(p, smem, vx, vl); gbar(bar, xcc, nloc, nx);
  run_phase<7>(p, smem, vx, vl); gbar(bar, xcc, nloc, nx);
  run_phase<8>(p, smem, vx, vl); gbar(bar, xcc, nloc, nx);
  run_phase<9>(p, smem); gbar(bar, xcc, nloc, nx);
  run_phase<10>(p, smem, vx, vl); gbar(bar, xcc, nloc, nx);
  run_phase<11>(p, smem, vx, vl); gbar(bar, xcc, nloc, nx);
  run_phase<12>(p, smem, vx, vl); gbar(bar, xcc, nloc, nx);
  run_phase<13>(p, smem);
}
#else
template <int PH>
__global__ void __launch_bounds__(256, 2) phase_kernel(P p) {
  __shared__ __attribute__((aligned(16))) char smem[65536];
  run_phase<PH>(p, smem);
}
#endif

extern "C" void kernel_launch(void* const* d_in, const int* in_sizes, int n_in, void* d_out, int out_size, void* d_ws,
                              size_t ws_size, hipStream_t stream) {
  P p{};
  const float** f = (const float**)&p;
  for (int i = 0; i < 27; ++i) f[i] = (const float*)d_in[i];
  p.out = (float*)d_out;
  p.ws = (char*)d_ws;
#if FUSED
  static int grid_blocks = 0;
  if (!grid_blocks) {
    int dev = 0, cus = 0, per_cu = 0;
    hipGetDevice(&dev);
    hipDeviceGetAttribute(&cus, hipDeviceAttributeMultiprocessorCount, dev);
    hipFuncSetAttribute((const void*)mega, hipFuncAttributeMaxDynamicSharedMemorySize, 131072 + 8192);
    hipOccupancyMaxActiveBlocksPerMultiprocessor(&per_cu, mega, 512, 131072 + 8192);
    if (per_cu > 1) per_cu = 1;
    grid_blocks = cus * per_cu;
  }
  hipMemsetAsync((char*)d_ws + BARO, 0, XCD_BAR_WORDS * 4, stream);
  void* args[] = {&p};
  hipError_t e = hipLaunchCooperativeKernel((void*)mega, dim3(grid_blocks), dim3(512), args, 131072 + 8192, stream);
  if (e != hipSuccess) fprintf(stderr, "cooperative launch failed: %s (grid %d)\n", hipGetErrorString(e), grid_blocks);
#else
  const int G = 512;
  phase_kernel<0><<<G, 256, 0, stream>>>(p);
  phase_kernel<1><<<G, 256, 0, stream>>>(p);
  phase_kernel<2><<<G, 256, 0, stream>>>(p);
  phase_kernel<3><<<G, 256, 0, stream>>>(p);
  phase_kernel<4><<<G, 256, 0, stream>>>(p);
  phase_kernel<5><<<G, 256, 0, stream>>>(p);
  phase_kernel<6><<<G, 256, 0, stream>>>(p);
  phase_kernel<7><<<G, 256, 0, stream>>>(p);
  phase_kernel<8><<<G, 256, 0, stream>>>(p);
  phase_kernel<9><<<G, 256, 0, stream>>>(p);
  phase_kernel<10><<<G, 256, 0, stream>>>(p);
  phase_kernel<11><<<G, 256, 0, stream>>>(p);
  phase_kernel<12><<<G, 256, 0, stream>>>(p);
  phase_kernel<13><<<G, 256, 0, stream>>>(p);
#endif
}
```

```cpp
#include <hip/hip_runtime.h>
#include <hip/hip_cooperative_groups.h>
#include <cstdio>
namespace cg = cooperative_groups;

#ifndef FUSED
#define FUSED 1
#endif

typedef unsigned short u16;
typedef __attribute__((ext_vector_type(8))) short bf16x8;
typedef __attribute__((ext_vector_type(4))) float f32x4;
#define DEV __device__ __forceinline__
__device__ __forceinline__ int tidx_() { int t = threadIdx.x; asm volatile("" : "+v"(t)); return t; }
#define VT (tidx_() & 255)
#define VHALF (tidx_() >> 8)
#define VBLK ((int)(blockIdx.x * 2) + (tidx_() >> 8))
#define VGRD ((int)(gridDim.x * 2))

constexpr int D = 1024, MP = 16384, MT = 129;
constexpr float EPS = 1e-6f;

constexpr size_t O_RETP = 16908288, O_RETS = 17432576, O_LRUP = 25821184, O_LRUS = 25825280,
                 O_CONVP = 25890816, O_CONVS = 25903104, O_SGUV = 26099712;
constexpr size_t W_INA = 0;
constexpr size_t W_OUTA = W_INA + 6291456;
constexpr size_t W_GU0 = W_OUTA + 2097152;
constexpr size_t W_D0 = W_GU0 + 11534336;
constexpr size_t W_INC = W_D0 + 5767168;
constexpr size_t W_OUTC = W_INC + 4194304;
constexpr size_t W_GU1 = W_OUTC + 2097152;
constexpr size_t W_D1 = W_GU1 + 11534336;
constexpr size_t XB = W_D1 + 5767168;
constexpr size_t ZB = XB + 33816576;
constexpr size_t YBO = ZB + 101449728;
constexpr size_t SSTO = YBO + 33816576;
constexpr size_t SS0 = SSTO + 16777216;
constexpr size_t SSSZ = 1056768;
constexpr size_t LNSO = SS0 + 5 * SSSZ;
constexpr size_t LNQO = LNSO + SSSZ;
constexpr size_t ROPEC = LNQO + SSSZ;
constexpr size_t ROPES = ROPEC + 524544;
constexpr size_t AGGP = ROPES + 524544;
constexpr size_t AGGH = AGGP + 262144;
constexpr size_t BARO = AGGH + 262144;
constexpr size_t UCO = BARO + 65536;

struct P {
  const float *x_prompt, *x_sample, *state_ret, *state_lru, *state_conv;
  const float *norm1, *norm2, *norm_f, *w_in_a, *ret_gn, *conv_w, *conv_b, *lru_wa, *lru_ba, *lru_wx, *lru_bx,
      *lru_lambda, *w_out_a, *w_in_c, *sg_norm_g, *sg_norm_b, *sg_ws, *sg_bs, *w_out_c, *ffn_wg, *ffn_wu, *ffn_wd;
  float* out;
  char* ws;
};

DEV void wconv_item(const P& p, float* tile, int tid, int item);
DEV u16 f2bf(float f) {
  unsigned u = __float_as_uint(f);
  u += 0x7fffu + ((u >> 16) & 1u);
  return (u16)(u >> 16);
}
DEV unsigned pk(float a, float b) { unsigned r; asm("v_cvt_pk_bf16_f32 %0, %1, %2" : "=v"(r) : "v"(a), "v"(b)); return r; }
DEV float blo(unsigned w) { return __uint_as_float(w << 16); }
DEV float bhi(unsigned w) { return __uint_as_float(w & 0xffff0000u); }
DEV float bf(u16 h) { return __uint_as_float(((unsigned)h) << 16); }
DEV void unpack8(uint4 v, float* f) {
  f[0] = blo(v.x); f[1] = bhi(v.x); f[2] = blo(v.y); f[3] = bhi(v.y);
  f[4] = blo(v.z); f[5] = bhi(v.z); f[6] = blo(v.w); f[7] = bhi(v.w);
}
DEV uint4 pack8(const float* f) { return make_uint4(pk(f[0], f[1]), pk(f[2], f[3]), pk(f[4], f[5]), pk(f[6], f[7])); }
DEV float wave_sum(float v) {
#pragma unroll
  for (int o = 32; o; o >>= 1) v += __shfl_xor(v, o);
  return v;
}
DEV float rcpf_(float x) { return __builtin_amdgcn_rcpf(x); }
DEV float sigmoidf_(float x) { return rcpf_(1.f + __expf(-x)); }
DEV float siluf_(float x) { return x * rcpf_(1.f + __expf(-x)); }
DEV float geluf_(float x) {
  float y2 = 1.5957691216057308f * (x + 0.044715f * x * x * x);
  return x * rcpf_(1.f + __expf(-y2));
}
DEV float lgh(int h) { return log1pf(-exp2f(-5.f - (float)h)); }

DEV int toff8(int row, int chunk) { return row * 128 + ((chunk ^ ((row >> 1) & 7)) << 4); }
DEV int toff16(int row, int chunk) { return row * 256 + ((chunk ^ (row & 15)) << 4); }
DEV int xoff(int t, int ch) { return t * 256 + ((((ch >> 2) ^ (t & 15))) << 4) + ((ch & 3) << 2); }
DEV int ooff(int i, int e) { return i * 512 + ((((e >> 2) ^ (i & 31))) << 4) + ((e & 3) << 2); }

template <int KC>
DEV void mma_tile(f32x4 (&acc)[4][4], const char* sA, const char* sB, int wm, int wn, int lane) {
  const int r = lane & 15, q = lane >> 4;
#pragma unroll KC == 8 ? 2 : 1
  for (int ks = 0; ks < KC / 4; ++ks) {
    bf16x8 a[4], b[4];
#pragma unroll
    for (int i = 0; i < 4; ++i) {
      int ra = wm * 64 + i * 16 + r, rb = wn * 64 + i * 16 + r;
      if (KC == 8) {
        a[i] = *(const bf16x8*)(sA + toff8(ra, ks * 4 + q));
        b[i] = *(const bf16x8*)(sB + toff8(rb, ks * 4 + q));
      } else {
        a[i] = *(const bf16x8*)(sA + toff16(ra, ks * 4 + q));
        b[i] = *(const bf16x8*)(sB + toff16(rb, ks * 4 + q));
      }
    }
#pragma unroll
    for (int mi = 0; mi < 4; ++mi)
#pragma unroll
      for (int ni = 0; ni < 4; ++ni)
        acc[mi][ni] = __builtin_amdgcn_mfma_f32_16x16x32_bf16(b[ni], a[mi], acc[mi][ni], 0, 0, 0);
  }
}

DEV void zero_acc(f32x4 (&acc)[4][4]) {
#pragma unroll
  for (int i = 0; i < 4; ++i)
#pragma unroll
    for (int j = 0; j < 4; ++j) acc[i][j] = f32x4{0.f, 0.f, 0.f, 0.f};
}

DEV float rstd16(const float* ss, int row) {
  const float4* s = (const float4*)(ss + (size_t)row * 16);
  float4 a = s[0], b = s[1], c = s[2], d = s[3];
  float t = (a.x + a.y + a.z + a.w) + (b.x + b.y + b.z + b.w) + (c.x + c.y + c.z + c.w) + (d.x + d.y + d.z + d.w);
  return rsqrtf(t * (1.f / 1024.f) + EPS);
}
DEV float rstd16_q(const float* ss, int row, int fq) {
  const float4 a = *(const float4*)(ss + (size_t)row * 16 + fq * 4);
  float t = (a.x + a.y) + (a.z + a.w);
  t += __shfl_xor(t, 16);
  t += __shfl_xor(t, 32);
  return rsqrtf(t * (1.f / 1024.f) + EPS);
}
DEV float sum16(const float* ss, int row) {
  const float4* s = (const float4*)(ss + (size_t)row * 16);
  float4 a = s[0], b = s[1], c = s[2], d = s[3];
  return (a.x + a.y + a.z + a.w) + (b.x + b.y + b.z + b.w) + (c.x + c.y + c.z + c.w) + (d.x + d.y + d.z + d.w);
}

enum { EPI_INA = 0, EPI_RES_IN, EPI_RES, EPI_GU, EPI_INC };

struct GArgs {
  const u16* A; int lda; const u16* B; int K; int ntn; int PM; int vx, vl;
  const float* ss;
  float* ssw;
  u16* o16;
  u16* o16b;
  float* resid;
  float* lns; float* lnq;
  const GArgs* next;
  const GArgs* prev;
  int prev_in;
  unsigned* cnt;
  int skip_sample;
  int wc_lo, wc_hi;
  int wc2_lo, wc2_hi;
};

template <int EPI>
DEV void gemm_tile8(const P& p, const GArgs& g, char* smem, int tn) {
  const int tid = tidx_(), lane = tid & 63, w = tid >> 6, wm = w >> 1, wn = w & 1;
  const int r = lane & 15, q = lane >> 4;
  f32x4 acc[2][4];
#pragma unroll
  for (int i = 0; i < 2; ++i)
#pragma unroll
    for (int j = 0; j < 4; ++j) acc[i][j] = f32x4{0.f, 0.f, 0.f, 0.f};
  const u16* ga = g.A + (size_t)MP * g.lda;
  const u16* gb = EPI == EPI_GU ? g.B : g.B + (size_t)(tn * 128) * g.K;
  size_t goa[2], gob[2];
  int lof[2];
#pragma unroll
  for (int i = 0; i < 2; ++i) {
    const int R = (i * 8 + w) * 8, row = R + (lane >> 3), chunk = (lane & 7) ^ ((row >> 1) & 7);
    goa[i] = (size_t)row * g.lda + chunk * 8;
    const int brow = EPI == EPI_GU ? ((tn >> 1) * 256 + (tn & 1) * 64 + ((row >> 5) << 4) + (row & 15) + ((row >> 4) & 1) * 128) : row;
    gob[i] = (size_t)brow * g.K + chunk * 8;
    lof[i] = R * 128 + lane * 16;
  }
  const int nk = g.K >> 6;
#define T8_ISSUE(kt_) do { char* d_ = smem + ((kt_) & 3) * 32768; const u16* pa_ = ga + (kt_) * 64; const u16* pb_ = gb + (kt_) * 64; \
    _Pragma("unroll") for (int i = 0; i < 2; ++i) { \
      __builtin_amdgcn_global_load_lds((const unsigned*)(pa_ + goa[i]), (unsigned*)(d_ + lof[i]), 16, 0, 0); \
      __builtin_amdgcn_global_load_lds((const unsigned*)(pb_ + gob[i]), (unsigned*)(d_ + 16384 + lof[i]), 16, 0, 0); } } while (0)
  T8_ISSUE(0); T8_ISSUE(1); T8_ISSUE(2);
  for (int kt = 0; kt < nk; ++kt) {
    if (kt + 2 < nk) asm volatile("s_waitcnt vmcnt(8)" ::: "memory");
    else if (kt + 1 < nk) asm volatile("s_waitcnt vmcnt(4)" ::: "memory");
    else asm volatile("s_waitcnt vmcnt(0)" ::: "memory");
    __builtin_amdgcn_s_barrier();
    asm volatile("" ::: "memory");
    if (kt + 3 < nk) T8_ISSUE(kt + 3);
    const char* sA = smem + (kt & 3) * 32768; const char* sB = sA + 16384;
#pragma unroll
    for (int ks = 0; ks < 2; ++ks) {
      bf16x8 a[2], b[4];
#pragma unroll
      for (int i = 0; i < 2; ++i) a[i] = *(const bf16x8*)(sA + toff8(wm * 32 + i * 16 + r, ks * 4 + q));
#pragma unroll
      for (int i = 0; i < 4; ++i) b[i] = *(const bf16x8*)(sB + toff8(wn * 64 + i * 16 + r, ks * 4 + q));
#pragma unroll
      for (int mi = 0; mi < 2; ++mi)
#pragma unroll
        for (int ni = 0; ni < 4; ++ni)
          acc[mi][ni] = __builtin_amdgcn_mfma_f32_16x16x32_bf16(b[ni], a[mi], acc[mi][ni], 0, 0, 0);
    }
  }
#undef T8_ISSUE
  asm volatile("s_waitcnt vmcnt(0) lgkmcnt(0)" ::: "memory");
  __builtin_amdgcn_s_barrier();
#pragma unroll
  for (int mi = 0; mi < 2; ++mi) {
    const int row = MP + wm * 32 + mi * 16 + r;
    if (EPI == EPI_INA) {
      const float rs = rstd16(g.ss, row);
#pragma unroll
      for (int ni = 0; ni < 4; ++ni) {
        const int col = tn * 128 + wn * 64 + ni * 16 + q * 4;
        f32x4 v = acc[mi][ni] * rs;
        *(uint2*)(g.o16 + (size_t)row * 3072 + col) = make_uint2(pk(v[0], v[1]), pk(v[2], v[3]));
      }
    } else if (EPI == EPI_RES_IN || EPI == EPI_RES) {
      float* xo = g.resid + (size_t)row * D;
      const float* xi = xo;
      if (EPI == EPI_RES_IN) xi = row < MP ? p.x_prompt + (size_t)row * D : p.x_sample + (size_t)(row - MP) * D;
      float ssum = 0.f;
#pragma unroll
      for (int ni = 0; ni < 4; ++ni) {
        const int col = tn * 128 + wn * 64 + ni * 16 + q * 4;
        float4 o;
        if (EPI == EPI_RES_IN) o = *(const float4*)(xi + col);
        else { const uint2 t = *(const uint2*)((const u16*)(p.ws + XB) + (size_t)row * D + col); o = make_float4(blo(t.x), bhi(t.x), blo(t.y), bhi(t.y)); }
        f32x4 a = acc[mi][ni];
        o.x += a[0]; o.y += a[1]; o.z += a[2]; o.w += a[3];
        ssum += o.x * o.x + o.y * o.y + o.z * o.z + o.w * o.w;
        if (g.o16) *(uint2*)(g.o16 + (size_t)row * D + col) = make_uint2(pk(o.x, o.y), pk(o.z, o.w));
        else *(float4*)(xo + col) = o;
      }
      ssum += __shfl_xor(ssum, 16);
      ssum += __shfl_xor(ssum, 32);
      if (q == 0 && g.o16) g.ssw[(size_t)row * 16 + tn * 2 + wn] = ssum;
    } else if (EPI == EPI_GU) {
      const float rs = rstd16(g.ss, row);
#pragma unroll
      for (int pp = 0; pp < 2; ++pp) {
        f32x4 gg = acc[mi][2 * pp] * rs, uu = acc[mi][2 * pp + 1] * rs;
        float o[4];
#pragma unroll
        for (int j = 0; j < 4; ++j) o[j] = siluf_(gg[j]) * uu[j];
        const int col = tn * 64 + wn * 32 + pp * 16 + q * 4;
        *(uint2*)(g.o16 + (size_t)row * 2816 + col) = make_uint2(pk(o[0], o[1]), pk(o[2], o[3]));
      }
    } else if (EPI == EPI_INC) {
      const float rs = rstd16(g.ss, row);
      float s1 = 0.f, s2 = 0.f;
#pragma unroll
      for (int ni = 0; ni < 4; ++ni) {
        const int col = tn * 128 + wn * 64 + ni * 16 + q * 4;
        f32x4 v = acc[mi][ni] * rs;
        float o[4];
#pragma unroll
        for (int j = 0; j < 4; ++j) { o[j] = geluf_(v[j]); s1 += o[j]; s2 += o[j] * o[j]; }
        u16* dst = tn < 8 ? g.o16 + (size_t)row * D + col : g.o16b + (size_t)row * D + (col - 1024);
        *(uint2*)dst = make_uint2(pk(o[0], o[1]), pk(o[2], o[3]));
      }
      if (tn >= 8) {
        s1 += __shfl_xor(s1, 16); s1 += __shfl_xor(s1, 32);
        s2 += __shfl_xor(s2, 16); s2 += __shfl_xor(s2, 32);
        if (q == 0) {
          g.lns[(size_t)row * 16 + (tn - 8) * 2 + wn] = s1;
          g.lnq[(size_t)row * 16 + (tn - 8) * 2 + wn] = s2;
        }
      }
    }
  }
}

namespace pg8 {
#define PG8_LAS __attribute__((address_space(3)))
constexpr int BM = 256, BK = 64, HALF = 128, HTB = HALF * BK * 2, NXCD = 8, WGM = 8;
DEV int lds_byte(int r, int c) { const int st = (r >> 4) * 2 + (c >> 5), rr = r & 15, cc = c & 31, ob = rr * 64 + cc * 2; return st * 1024 + (ob ^ (((ob >> 9) & 1) << 5)); }
DEV void stage_rc(int b, int& R, int& C) { const int st = b / 1024, sb = b % 1024, swz = sb ^ (((sb >> 9) & 1) << 5); R = (st >> 1) * 16 + swz / 64; C = (st & 1) * 32 + (swz % 64) / 2; }
DEV int perm32(int rho) { const int n = rho >> 4, i = rho & 15; return 8 * (i >> 2) + 4 * n + (i & 3); }
struct Unit { int pm, pn; };
struct Gemm { const u16* A; const u16* Bt; int M, N, K; };
struct StaticOrder {
  int nM, nN, nwg, G, c;
  DEV void init(int M, int N, int G_, int c_) { nM = M / BM; nN = N / BM; nwg = nM * nN; G = G_; c = c_; }
  DEV bool next(int i, Unit& u) const {
    const long L = (long)i * G + c; if (L >= nwg) return false;
    int wgid = (int)L; { const int q = nwg / NXCD, r = nwg % NXCD, xcd = wgid % NXCD, off = wgid / NXCD; wgid = (xcd < r ? xcd * (q + 1) : r * (q + 1) + (xcd - r) * q) + off; }
    const int nig = WGM * nN, gid = wgid / nig, fm = gid * WGM, gsz = (nM - fm) < WGM ? (nM - fm) : WGM;
    u.pm = fm + ((wgid % nig) % gsz); u.pn = (wgid % nig) / gsz; return true;
  }
};
template <class Epi, class Sched>
DEV void gemm_phase(PG8_LAS unsigned char* lds, const Gemm g, const Sched& S, const Epi& E) {
  const int tid = threadIdx.x, wid = __builtin_amdgcn_readfirstlane(tid >> 6), lane = tid & 63, wr = wid >> 2, wc = wid & 3, fr = lane & 15, fq = lane >> 4;
  const int K = g.K, nt = K / BK;
  unsigned voffA[2], voffB[2];
#pragma unroll
  for (int i = 0; i < 2; ++i) { int R, C; stage_rc(tid * 16 + i * 8192, R, C); const int Rb = Epi::PERM ? ((R & ~31) + perm32(R & 31)) : R;
    voffA[i] = (unsigned)(R * K + C) * 2u; voffB[i] = (unsigned)(Rb * K + C) * 2u; }
  const size_t kstep = (size_t)(BK * 2);
  const size_t hstep = (size_t)HALF * K * 2;
  const size_t tstep = 2 * hstep;
  const unsigned ldsw = (unsigned)wid * 1024u;
  const int aoff = lds_byte(wr * 64 + fr, fq * 8), boff = lds_byte(wc * 32 + fr, fq * 8);
#define PG8_SA(b, h) (((b) * 2 + (h)) * HTB)
#define PG8_SB(b, h) ((4 + (b) * 2 + (h)) * HTB)
#define PG8_STAGE(bufoff, gbase, voff) do { _Pragma("unroll") for (int _i = 0; _i < 2; ++_i) \
    __builtin_amdgcn_global_load_lds((const unsigned*)((const char*)(gbase) + (voff)[_i]), (PG8_LAS unsigned*)(lds + (bufoff) + ldsw + _i * 8192), 16, 0, 0); } while (0)
#define PG8_LDA(dst, b, h) do { _Pragma("unroll") for (int m = 0; m < 4; ++m) _Pragma("unroll") for (int k = 0; k < 2; ++k) dst[m][k] = *(const PG8_LAS bf16x8*)(lds + PG8_SA(b, h) + aoff + m * 2048 + k * 1024); } while (0)
#define PG8_LDB(dst, b, h) do { _Pragma("unroll") for (int n = 0; n < 2; ++n) _Pragma("unroll") for (int k = 0; k < 2; ++k) dst[n][k] = *(const PG8_LAS bf16x8*)(lds + PG8_SB(b, h) + boff + n * 2048 + k * 1024); } while (0)
#define PG8_MMA(ai, bj, At, Bt) do { __builtin_amdgcn_s_setprio(1); _Pragma("unroll") for (int m = 0; m < 4; ++m) _Pragma("unroll") for (int n = 0; n < 2; ++n) _Pragma("unroll") for (int k = 0; k < 2; ++k) \
    acc[ai][bj][m][n] = __builtin_amdgcn_mfma_f32_16x16x32_bf16(Bt[n][k], At[m][k], acc[ai][bj][m][n], 0, 0, 0); __builtin_amdgcn_s_setprio(0); } while (0)
#define PG8_WAIT_V(n) asm volatile("s_waitcnt vmcnt(" #n ")" ::: "memory")
#define PG8_WAIT_L(n) asm volatile("s_waitcnt lgkmcnt(" #n ")" ::: "memory")
#define PG8_BAR __builtin_amdgcn_s_barrier()
#define PG8_SCHED __builtin_amdgcn_sched_barrier(0)
  Unit cur, nxt; int ui = 0;
  if (!S.next(0, cur)) return;
  f32x4 acc[2][2][4][2];
#pragma unroll
  for (int a = 0; a < 2; ++a)
#pragma unroll
    for (int b = 0; b < 2; ++b)
#pragma unroll
      for (int m = 0; m < 4; ++m)
#pragma unroll
        for (int n = 0; n < 2; ++n) acc[a][b][m][n] = (f32x4){0.f, 0.f, 0.f, 0.f};
  bf16x8 At[4][2], B0[2][2], B1[2][2];
  const char* cA = (const char*)g.A + (size_t)cur.pm * tstep; const char* cB = (const char*)g.Bt + (size_t)cur.pn * tstep;
  PG8_STAGE(PG8_SB(0, 0), cB, voffB); PG8_STAGE(PG8_SA(0, 0), cA, voffA); PG8_STAGE(PG8_SB(0, 1), cB + hstep, voffB); PG8_STAGE(PG8_SA(0, 1), cA + hstep, voffA);
  if (wr == 1) PG8_BAR;
  PG8_WAIT_V(4); PG8_BAR;
  PG8_STAGE(PG8_SB(1, 0), cB + kstep, voffB); PG8_STAGE(PG8_SA(1, 0), cA + kstep, voffA); PG8_STAGE(PG8_SB(1, 1), cB + hstep + kstep, voffB);
  PG8_WAIT_V(6); PG8_BAR;
  for (;;) {
    const bool has_next = S.next(ui + 1, nxt);
    const char* nA = has_next ? (const char*)g.A + (size_t)nxt.pm * tstep : cA; const char* nB = has_next ? (const char*)g.Bt + (size_t)nxt.pn * tstep : cB;
    for (int t = 0; t < nt; t += 2) {
      const bool last = (t == nt - 2);
      const char* a1 = cA + (size_t)(t + 1) * kstep;
      const char* a2 = last ? nA : cA + (size_t)(t + 2) * kstep; const char* b2 = last ? nB : cB + (size_t)(t + 2) * kstep;
      const char* a3 = a2 + kstep; const char* b3 = b2 + kstep;
      PG8_LDB(B0, 0, 0); PG8_SCHED; PG8_LDA(At, 0, 0); PG8_STAGE(PG8_SA(1, 1), a1 + hstep, voffA);
      PG8_WAIT_L(8); PG8_BAR; PG8_WAIT_L(0); PG8_MMA(0, 0, At, B0); PG8_BAR; PG8_SCHED;
      PG8_LDB(B1, 0, 1); PG8_STAGE(PG8_SB(0, 0), b2, voffB);
      PG8_BAR; PG8_WAIT_L(0); PG8_MMA(0, 1, At, B1); PG8_BAR;
      PG8_LDA(At, 0, 1); PG8_STAGE(PG8_SA(0, 0), a2, voffA);
      PG8_BAR; PG8_WAIT_L(0); PG8_MMA(1, 0, At, B0); PG8_BAR; PG8_SCHED;
      PG8_STAGE(PG8_SB(0, 1), b2 + hstep, voffB);
      PG8_WAIT_V(6); PG8_BAR; PG8_MMA(1, 1, At, B1); PG8_BAR;
      PG8_LDB(B0, 1, 0); PG8_SCHED; PG8_LDA(At, 1, 0); PG8_STAGE(PG8_SA(0, 1), a2 + hstep, voffA);
      PG8_WAIT_L(8); PG8_BAR; PG8_WAIT_L(0); PG8_MMA(0, 0, At, B0); PG8_BAR; PG8_SCHED;
      PG8_LDB(B1, 1, 1); PG8_STAGE(PG8_SB(1, 0), b3, voffB);
      PG8_BAR; PG8_WAIT_L(0); PG8_MMA(0, 1, At, B1); PG8_BAR;
      PG8_LDA(At, 1, 1); PG8_STAGE(PG8_SA(1, 0), a3, voffA);
      PG8_BAR; PG8_WAIT_L(0); PG8_MMA(1, 0, At, B0); PG8_BAR; PG8_SCHED;
      PG8_STAGE(PG8_SB(1, 1), b3 + hstep, voffB);
      PG8_WAIT_V(6); PG8_BAR; PG8_MMA(1, 1, At, B1); PG8_BAR;
    }
    E(acc, cur, ui, wr, wc, fr, fq);
    if (!has_next) break;
#pragma unroll
    for (int a = 0; a < 2; ++a)
#pragma unroll
      for (int b = 0; b < 2; ++b)
#pragma unroll
        for (int m = 0; m < 4; ++m)
#pragma unroll
          for (int n = 0; n < 2; ++n) acc[a][b][m][n] = (f32x4){0.f, 0.f, 0.f, 0.f};
    cur = nxt; cA = nA; cB = nB; ++ui;
  }
  PG8_WAIT_V(0);
  if (wr == 0) PG8_BAR;
  PG8_BAR;
#undef PG8_SA
#undef PG8_SB
#undef PG8_STAGE
#undef PG8_LDA
#undef PG8_LDB
#undef PG8_MMA
#undef PG8_WAIT_V
#undef PG8_WAIT_L
#undef PG8_BAR
#undef PG8_SCHED
}
}

template <int EPI>
struct Epi8 {
  static constexpr bool PERM = true;
  GArgs g; const P* p;
  const PG8_LAS float* rsl;
  DEV void operator()(const f32x4 (&acc)[2][2][4][2], const pg8::Unit& u, int ui, int wr, int wc, int fr, int fq) const {
    const int rbase = u.pm * 256 + wr * 64 + fr;
    float rsv[2][4];
    if (EPI == EPI_INA || EPI == EPI_GU || EPI == EPI_INC) {
#pragma unroll
      for (int ai = 0; ai < 2; ++ai)
#pragma unroll
        for (int m = 0; m < 4; ++m) rsv[ai][m] = rsl[ui * 256 + ai * 128 + wr * 64 + m * 16 + fr];
    }
#pragma unroll
    for (int ai = 0; ai < 2; ++ai) {
      if (EPI == EPI_RES_IN || EPI == EPI_RES) {
        float o[4][2][8];
        if (EPI == EPI_RES_IN) {
          float4 x4[4][2][2];
#pragma unroll
          for (int m = 0; m < 4; ++m)
#pragma unroll
            for (int bj = 0; bj < 2; ++bj) {
              const float* xp = p->x_prompt + (size_t)(rbase + ai * 128 + m * 16) * D + u.pn * 256 + bj * 128 + wc * 32 + 8 * fq;
              x4[m][bj][0] = *(const float4*)xp; x4[m][bj][1] = *(const float4*)(xp + 4);
            }
          asm volatile("s_waitcnt vmcnt(0)" ::: "memory");
#pragma unroll
          for (int m = 0; m < 4; ++m)
#pragma unroll
            for (int bj = 0; bj < 2; ++bj) {
              o[m][bj][0] = x4[m][bj][0].x; o[m][bj][1] = x4[m][bj][0].y; o[m][bj][2] = x4[m][bj][0].z; o[m][bj][3] = x4[m][bj][0].w;
              o[m][bj][4] = x4[m][bj][1].x; o[m][bj][5] = x4[m][bj][1].y; o[m][bj][6] = x4[m][bj][1].z; o[m][bj][7] = x4[m][bj][1].w;
            }
        } else {
          uint4 x8[4][2];
#pragma unroll
          for (int m = 0; m < 4; ++m)
#pragma unroll
            for (int bj = 0; bj < 2; ++bj)
              x8[m][bj] = *(const uint4*)((const u16*)(p->ws + XB) + (size_t)(rbase + ai * 128 + m * 16) * D + u.pn * 256 + bj * 128 + wc * 32 + 8 * fq);
          asm volatile("s_waitcnt vmcnt(0)" ::: "memory");
#pragma unroll
          for (int m = 0; m < 4; ++m)
#pragma unroll
            for (int bj = 0; bj < 2; ++bj) unpack8(x8[m][bj], o[m][bj]);
        }
#pragma unroll
        for (int m = 0; m < 4; ++m) {
          const int row = rbase + ai * 128 + m * 16;
          float ssum = 0.f;
#pragma unroll
          for (int bj = 0; bj < 2; ++bj) {
            const int col0 = u.pn * 256 + bj * 128 + wc * 32 + 8 * fq;
            const f32x4 a0 = acc[ai][bj][m][0], a1 = acc[ai][bj][m][1];
#pragma unroll
            for (int j = 0; j < 4; ++j) { o[m][bj][j] += a0[j]; o[m][bj][4 + j] += a1[j]; }
#pragma unroll
            for (int j = 0; j < 8; ++j) ssum += o[m][bj][j] * o[m][bj][j];
            *(uint4*)(g.o16 + (size_t)row * D + col0) = pack8(o[m][bj]);
          }
          ssum += __shfl_xor(ssum, 16);
          ssum += __shfl_xor(ssum, 32);
          if (fq == 0) g.ssw[(size_t)row * 16 + u.pn * 4 + wc] = ssum;
        }
      } else {
#pragma unroll
        for (int m = 0; m < 4; ++m) {
          const int row = rbase + ai * 128 + m * 16;
          const float rs = rsv[ai][m];
          if (EPI == EPI_INA) {
#pragma unroll
            for (int bj = 0; bj < 2; ++bj) {
              const int col0 = u.pn * 256 + bj * 128 + wc * 32 + 8 * fq;
              f32x4 v0 = acc[ai][bj][m][0] * rs, v1 = acc[ai][bj][m][1] * rs;
              *(uint4*)(g.o16 + (size_t)row * 3072 + col0) = make_uint4(pk(v0[0], v0[1]), pk(v0[2], v0[3]), pk(v1[0], v1[1]), pk(v1[2], v1[3]));
            }
          } else if (EPI == EPI_GU) {
            const f32x4 g0 = acc[ai][0][m][0] * rs, g1 = acc[ai][0][m][1] * rs, u0 = acc[ai][1][m][0] * rs, u1 = acc[ai][1][m][1] * rs;
            float o[8];
#pragma unroll
            for (int j = 0; j < 4; ++j) { o[j] = siluf_(g0[j]) * u0[j]; o[4 + j] = siluf_(g1[j]) * u1[j]; }
            const int col = u.pn * 128 + wc * 32 + 8 * fq;
            *(uint4*)(g.o16 + (size_t)row * 2816 + col) = pack8(o);
          } else if (EPI == EPI_INC) {
            float s1 = 0.f, s2 = 0.f;
#pragma unroll
            for (int bj = 0; bj < 2; ++bj) {
              const int col0 = u.pn * 256 + bj * 128 + wc * 32 + 8 * fq;
              f32x4 v0 = acc[ai][bj][m][0] * rs, v1 = acc[ai][bj][m][1] * rs;
              float o[8];
#pragma unroll
              for (int j = 0; j < 4; ++j) { o[j] = geluf_(v0[j]); o[4 + j] = geluf_(v1[j]); }
#pragma unroll
              for (int j = 0; j < 8; ++j) { s1 += o[j]; s2 += o[j] * o[j]; }
              u16* dst = u.pn < 4 ? g.o16 + (size_t)row * D + col0 : g.o16b + (size_t)row * D + (col0 - 1024);
              *(uint4*)dst = pack8(o);
            }
            if (u.pn >= 4) {
              s1 += __shfl_xor(s1, 16); s1 += __shfl_xor(s1, 32);
              s2 += __shfl_xor(s2, 16); s2 += __shfl_xor(s2, 32);
              if (fq == 0) {
                g.lns[(size_t)row * 16 + (u.pn - 4) * 4 + wc] = s1;
                g.lnq[(size_t)row * 16 + (u.pn - 4) * 4 + wc] = s2;
              }
            }
          }
        }
      }
    }
  }
};

DEV void handoff_publish(unsigned* cnt) {
  asm volatile("s_waitcnt vmcnt(0)" ::: "memory");
  __syncthreads();
  if (threadIdx.x == 0) {
    __builtin_amdgcn_fence(__ATOMIC_RELEASE, "agent");
    asm volatile("s_waitcnt vmcnt(0)" ::: "memory");
    __hip_atomic_fetch_add(cnt, 1u, __ATOMIC_RELAXED, __HIP_MEMORY_SCOPE_AGENT);
  }
  __syncthreads();
}
DEV void handoff_wait(unsigned* cnt, unsigned need) {
  if (threadIdx.x == 0) {
    unsigned sp = 0;
    while (__hip_atomic_load(cnt, __ATOMIC_RELAXED, __HIP_MEMORY_SCOPE_AGENT) < need) {
      __builtin_amdgcn_s_sleep(2);
      if (++sp > (1u << 22)) break;
    }
    __builtin_amdgcn_fence(__ATOMIC_ACQUIRE, "agent");
    asm volatile("s_waitcnt vmcnt(0)" ::: "memory");
  }
  __syncthreads();
}

template <int EPI>
__device__ void gemm_phase(const P& p, const GArgs& g, char* smem) {
  const int j = (int)gridDim.x - 1 - (int)blockIdx.x;
  const bool chain = (EPI == EPI_GU) && g.next != nullptr;
  if (chain) {
    const int jp = j - g.ntn - g.next->ntn;
    if (jp >= 0 && jp < g.prev->ntn) {
      if (g.prev_in) gemm_tile8<EPI_RES_IN>(p, *g.prev, smem, jp);
      else gemm_tile8<EPI_RES>(p, *g.prev, smem, jp);
      handoff_publish(g.cnt);
    }
    if (j < g.ntn) {
      if (g.wc2_hi > g.wc2_lo) {
        const int vb = j * 2 + VHALF;
        float* tile = (float*)(smem + VHALF * 65536);
        const int tidl = VT;
        for (int it = g.wc2_lo + vb; it < g.wc2_hi; it += 2 * g.ntn) wconv_item(p, tile, tidl, it);
      }
      handoff_wait(g.cnt, (unsigned)g.prev->ntn);
      gemm_tile8<EPI>(p, g, smem, j);
      handoff_publish(g.cnt + 16);
    }
  }
  {
    pg8::Gemm gm{g.A, g.B, MP, g.ntn * 128, g.K};
    pg8::StaticOrder S;
    S.init(MP, g.ntn * 128, (int)gridDim.x, (int)blockIdx.x);
    PG8_LAS float* rsl = (PG8_LAS float*)((PG8_LAS unsigned char*)smem + 131072);
    if (EPI == EPI_INA || EPI == EPI_GU || EPI == EPI_INC) {
      const int t = tidx_();
      pg8::Unit u0;
      for (int i = (t >> 8); S.next(i, u0); i += 2) rsl[i * 256 + (t & 255)] = rstd16(g.ss, u0.pm * 256 + (t & 255));
      __syncthreads();
    }
    Epi8<EPI> E{g, &p, rsl};
    pg8::gemm_phase(( PG8_LAS unsigned char*)smem, gm, S, E);
  }
  if (chain) {
    if (j >= g.ntn && j < g.ntn + g.next->ntn) {
      handoff_wait(g.cnt + 16, (unsigned)g.ntn);
      gemm_tile8<EPI_RES>(p, *g.next, smem, j - g.ntn);
    } else if (j >= 60 && j < 128) {
      const int vb = (j - 60) * 2 + VHALF;
      float* tile = (float*)(smem + VHALF * 65536);
      const int tidl = VT;
      for (int it = g.wc_lo + vb; it < g.wc_hi; it += 136) wconv_item(p, tile, tidl, it);
    }
  } else if (!g.skip_sample) {
    if (j < g.ntn) gemm_tile8<EPI>(p, g, smem, j);
  }
}

DEV void wconv_item(const P& p, float* tile, int tid, int item) {
  int it = item;
  const float* src; const float* gain = nullptr; int K = 1024, N = 1024, mode = 0; size_t dsto;
  if (it < 384) { src = p.w_in_a; N = 3072; gain = p.norm1; dsto = W_INA; }
  else if ((it -= 384) < 128) { src = p.w_out_a; dsto = W_OUTA; }
  else if ((it -= 128) < 352) { src = p.ffn_wg; N = 2816; gain = p.norm2; dsto = W_GU0; mode = 1; }
  else if ((it -= 352) < 352) { src = p.ffn_wu; N = 2816; gain = p.norm2; dsto = W_GU0; mode = 2; }
  else if ((it -= 352) < 352) { src = p.ffn_wd; K = 2816; dsto = W_D0; }
  else if ((it -= 352) < 256) { src = p.w_in_c; N = 2048; gain = p.norm1 + 1024; dsto = W_INC; }
  else if ((it -= 256) < 128) { src = p.w_out_c; dsto = W_OUTC; }
  else if ((it -= 128) < 352) { src = p.ffn_wg + (size_t)1024 * 2816; N = 2816; gain = p.norm2 + 1024; dsto = W_GU1; mode = 1; }
  else if ((it -= 352) < 352) { src = p.ffn_wu + (size_t)1024 * 2816; N = 2816; gain = p.norm2 + 1024; dsto = W_GU1; mode = 2; }
  else { it -= 352; src = p.ffn_wd + (size_t)2816 * 1024; K = 2816; dsto = W_D1; }
  u16* dst = (u16*)(p.ws + dsto);
  const int ntn = N >> 7;
  const int kt = it / ntn, nt = it - kt * ntn, k0 = kt * 64, n0 = nt * 128;
  {
    const int nn = tid & 127, kh = tid >> 7;
    float v[32];
#pragma unroll
    for (int i = 0; i < 32; ++i) v[i] = src[(size_t)(k0 + kh + 2 * i) * N + n0 + nn];
    if (gain) {
#pragma unroll
      for (int i = 0; i < 32; ++i) v[i] *= gain[k0 + kh + 2 * i];
    }
#pragma unroll
    for (int i = 0; i < 32; ++i) tile[(kh + 2 * i) * 129 + nn] = v[i];
  }
  __syncthreads();
  {
    const int nn = tid >> 1, kc = (tid & 1) * 32;
    unsigned wv[16];
#pragma unroll
    for (int j = 0; j < 16; ++j) wv[j] = pk(tile[(kc + 2 * j) * 129 + nn], tile[(kc + 2 * j + 1) * 129 + nn]);
    const int n = n0 + nn;
    const int drow = mode == 0 ? n : ((n >> 7) * 256 + (n & 127) + (mode == 2 ? 128 : 0));
    uint4* d = (uint4*)(dst + (size_t)drow * K + k0 + kc);
    d[0] = make_uint4(wv[0], wv[1], wv[2], wv[3]);
    d[1] = make_uint4(wv[4], wv[5], wv[6], wv[7]);
    d[2] = make_uint4(wv[8], wv[9], wv[10], wv[11]);
    d[3] = make_uint4(wv[12], wv[13], wv[14], wv[15]);
  }
  __syncthreads();
}

__device__ void phase0(const P& p, char* smem) {
  smem += VHALF * 65536;
  const int tid = VT, lane = tid & 63;
  float* tile = (float*)smem;
  constexpr int NW = 1568, NX = 2064, NR = 513;
  for (int item = VBLK; item < NW + NX + NR; item += VGRD) {
    if (item < NW) {
      wconv_item(p, tile, tid, item);
    } else if (item < NW + NX) {
      const int row0 = (item - NW) * 8 + (tid >> 6) * 2;
      float4 v[2][4];
#pragma unroll
      for (int rr = 0; rr < 2; ++rr) {
        const int row = row0 + rr;
        const float* src = row < MP ? p.x_prompt + (size_t)row * D : p.x_sample + (size_t)(row - MP) * D;
#pragma unroll
        for (int i = 0; i < 4; ++i) v[rr][i] = ((const float4*)src)[lane + 64 * i];
      }
#pragma unroll
      for (int rr = 0; rr < 2; ++rr) {
        const int row = row0 + rr;
        u16* xb = (u16*)(p.ws + XB) + (size_t)row * D;
        float ss = 0.f;
#pragma unroll
        for (int i = 0; i < 4; ++i) {
          const float4 q = v[rr][i];
          ss += q.x * q.x + q.y * q.y + q.z * q.z + q.w * q.w;
          ((uint2*)xb)[lane + 64 * i] = make_uint2(pk(q.x, q.y), pk(q.z, q.w));
        }
        ss = wave_sum(ss);
        if (lane < 16) ((float*)(p.ws + SS0))[(size_t)row * 16 + lane] = lane == 0 ? ss : 0.f;
      }
    } else {
      int idx = (item - NW - NX) * 256 + tid;
      if (idx < 2049 * 64) {
        int pi = idx >> 6, i = idx & 63;
        float pos = pi < 2048 ? (float)pi : 16384.f;
        float inv = powf(10000.f, -(float)i / 64.f);
        float ang = pos * inv;
        double a = (double)ang;
        double kq = rint(a * 0.15915494309189535);
        double rr = a - kq * 6.283185307179586;
        float rf = (float)rr;
        ((float*)(p.ws + ROPEC))[idx] = cosf(rf);
        ((float*)(p.ws + ROPES))[idx] = sinf(rf);
      }
    }
  }
}

template <class F>
DEV void load_T(int tid, char* sT, const u16* src, size_t ld, F xf) {
  const int jp = tid & 63, cgp = tid >> 6;
  const u16* s0 = src + (size_t)(2 * jp) * ld + cgp * 32;
  const u16* s1 = s0 + ld;
  const int cb = ((jp >> 2)), bo = (jp & 3) * 4;
#pragma unroll
  for (int h = 0; h < 4; ++h) {
    uint4 a = *(const uint4*)(s0 + h * 8), b = *(const uint4*)(s1 + h * 8);
    float fa[8], fb[8];
    unpack8(a, fa); unpack8(b, fb);
#pragma unroll
    for (int e = 0; e < 8; ++e) {
      int c = cgp * 32 + h * 8 + e;
      *(unsigned*)(sT + toff16(c, cb) + bo) = pk(xf(0, c, fa[e]), xf(1, c, fb[e]));
    }
  }
}
DEV void load_T_ln(int tid, char* sT, const u16* src, size_t ld, float m0, float rs0, float m1, float rs1, const float* vg, const float* vb) {
  const int jp = tid & 63, cgp = tid >> 6;
  const u16* s0 = src + (size_t)(2 * jp) * ld + cgp * 32;
  const u16* s1 = s0 + ld;
  const int cb = ((jp >> 2)), bo = (jp & 3) * 4;
#pragma unroll
  for (int h = 0; h < 4; ++h) {
    uint4 a = *(const uint4*)(s0 + h * 8), b = *(const uint4*)(s1 + h * 8);
    const float4 g0 = *(const float4*)(vg + cgp * 32 + h * 8), g1 = *(const float4*)(vg + cgp * 32 + h * 8 + 4);
    const float4 b0 = *(const float4*)(vb + cgp * 32 + h * 8), b1 = *(const float4*)(vb + cgp * 32 + h * 8 + 4);
    const float gv[8] = {g0.x, g0.y, g0.z, g0.w, g1.x, g1.y, g1.z, g1.w};
    const float bv[8] = {b0.x, b0.y, b0.z, b0.w, b1.x, b1.y, b1.z, b1.w};
    float fa[8], fb[8];
    unpack8(a, fa); unpack8(b, fb);
#pragma unroll
    for (int e = 0; e < 8; ++e) {
      const int c = cgp * 32 + h * 8 + e;
      const float ga = gv[e] * rs0, gb2 = gv[e] * rs1;
      *(unsigned*)(sT + toff16(c, cb) + bo) = pk((fa[e] - m0) * ga + bv[e], (fb[e] - m1) * gb2 + bv[e]);
    }
  }
}
DEV void load_rot(int tid, char* sT, const u16* src, size_t ld, const float* cs, const float* sn, float scale) {
  const int i = tid >> 1, half = tid & 1;
  const u16* s = src + (size_t)i * ld + half * 32;
  const float* c_ = cs + (size_t)i * 64 + half * 32;
  const float* s_ = sn + (size_t)i * 64 + half * 32;
#pragma unroll
  for (int h = 0; h < 4; ++h) {
    uint4 lo = *(const uint4*)(s + h * 8), hi = *(const uint4*)(s + 64 + h * 8);
    float fl[8], fh[8], ol[8], oh[8];
    unpack8(lo, fl); unpack8(hi, fh);
    float4 c0 = *(const float4*)(c_ + h * 8), c1 = *(const float4*)(c_ + h * 8 + 4);
    float4 s0 = *(const float4*)(s_ + h * 8), s1 = *(const float4*)(s_ + h * 8 + 4);
    float cc[8] = {c0.x, c0.y, c0.z, c0.w, c1.x, c1.y, c1.z, c1.w};
    float sv[8] = {s0.x, s0.y, s0.z, s0.w, s1.x, s1.y, s1.z, s1.w};
#pragma unroll
    for (int e = 0; e < 8; ++e) {
      ol[e] = (fl[e] * cc[e] - fh[e] * sv[e]) * scale;
      oh[e] = (fh[e] * cc[e] + fl[e] * sv[e]) * scale;
    }
    *(uint4*)(sT + toff16(i, half * 4 + h)) = pack8(ol);
    *(uint4*)(sT + toff16(i, 8 + half * 4 + h)) = pack8(oh);
  }
}
DEV void load_rot_T(int tid, char* sT, const u16* src, size_t ld, const float* cs, const float* sn) {
  const int jp = tid & 63, w = tid >> 6;
  const u16* s0 = src + (size_t)(2 * jp) * ld + w * 16;
  const u16* s1 = s0 + ld;
  const float* c0p = cs + (size_t)(2 * jp) * 64 + w * 16;
  const float* s0p = sn + (size_t)(2 * jp) * 64 + w * 16;
  const int cb = jp >> 2, bo = (jp & 3) * 4;
#pragma unroll
  for (int h = 0; h < 2; ++h) {
    float fl0[8], fh0[8], fl1[8], fh1[8];
    unpack8(*(const uint4*)(s0 + h * 8), fl0); unpack8(*(const uint4*)(s0 + 64 + h * 8), fh0);
    unpack8(*(const uint4*)(s1 + h * 8), fl1); unpack8(*(const uint4*)(s1 + 64 + h * 8), fh1);
#pragma unroll
    for (int e4 = 0; e4 < 2; ++e4) {
      float4 ca = *(const float4*)(c0p + h * 8 + e4 * 4), sa = *(const float4*)(s0p + h * 8 + e4 * 4);
      float4 cb4 = *(const float4*)(c0p + 64 + h * 8 + e4 * 4), sb4 = *(const float4*)(s0p + 64 + h * 8 + e4 * 4);
      float c0a[4] = {ca.x, ca.y, ca.z, ca.w}, s0a[4] = {sa.x, sa.y, sa.z, sa.w};
      float c1a[4] = {cb4.x, cb4.y, cb4.z, cb4.w}, s1a[4] = {sb4.x, sb4.y, sb4.z, sb4.w};
#pragma unroll
      for (int e = 0; e < 4; ++e) {
        int ee = e4 * 4 + e;
        int d = w * 16 + h * 8 + ee;
        float l0 = fl0[ee] * c0a[e] - fh0[ee] * s0a[e], h0 = fh0[ee] * c0a[e] + fl0[ee] * s0a[e];
        float l1 = fl1[ee] * c1a[e] - fh1[ee] * s1a[e], h1 = fh1[ee] * c1a[e] + fl1[ee] * s1a[e];
        *(unsigned*)(sT + toff16(d, cb) + bo) = pk(l0, l1);
        *(unsigned*)(sT + toff16(d + 64, cb) + bo) = pk(h0, h1);
      }
    }
  }
}
DEV void load_N(int tid, char* sT, const u16* src, size_t ld) {
#pragma unroll
  for (int i = 0; i < 8; ++i) {
    int idx = tid + 256 * i, row = idx >> 4, ch = idx & 15;
    *(uint4*)(sT + toff16(row, ch)) = *(const uint4*)(src + (size_t)row * ld + ch * 8);
  }
}

struct RotTab { float4 c[8], s[8]; };
struct RotDat { uint4 lo[4], hi[4]; };
DEV void rot_tab_issue(RotTab& T, int tid, const float* cs, const float* sn) {
  const int i = tid >> 1, half = tid & 1;
  const float* c_ = cs + (size_t)i * 64 + half * 32;
  const float* s_ = sn + (size_t)i * 64 + half * 32;
#pragma unroll
  for (int h = 0; h < 4; ++h) {
    T.c[2 * h] = *(const float4*)(c_ + h * 8); T.c[2 * h + 1] = *(const float4*)(c_ + h * 8 + 4);
    T.s[2 * h] = *(const float4*)(s_ + h * 8); T.s[2 * h + 1] = *(const float4*)(s_ + h * 8 + 4);
  }
}
DEV void rot_dat_issue(RotDat& R, int tid, const u16* src, size_t ld) {
  const int i = tid >> 1, half = tid & 1;
  const u16* s = src + (size_t)i * ld + half * 32;
#pragma unroll
  for (int h = 0; h < 4; ++h) { R.lo[h] = *(const uint4*)(s + h * 8); R.hi[h] = *(const uint4*)(s + 64 + h * 8); }
}
DEV void rot_commit(const RotDat& R, const RotTab& T, int tid, char* sT, float scale) {
  const int i = tid >> 1, half = tid & 1;
#pragma unroll
  for (int h = 0; h < 4; ++h) {
    float fl[8], fh[8], ol[8], oh[8];
    unpack8(R.lo[h], fl); unpack8(R.hi[h], fh);
    const float4 c0 = T.c[2 * h], c1 = T.c[2 * h + 1], s0 = T.s[2 * h], s1 = T.s[2 * h + 1];
    const float cc[8] = {c0.x, c0.y, c0.z, c0.w, c1.x, c1.y, c1.z, c1.w};
    const float sv[8] = {s0.x, s0.y, s0.z, s0.w, s1.x, s1.y, s1.z, s1.w};
#pragma unroll
    for (int e = 0; e < 8; ++e) {
      ol[e] = (fl[e] * cc[e] - fh[e] * sv[e]) * scale;
      oh[e] = (fh[e] * cc[e] + fl[e] * sv[e]) * scale;
    }
    *(uint4*)(sT + toff16(i, half * 4 + h)) = pack8(ol);
    *(uint4*)(sT + toff16(i, 8 + half * 4 + h)) = pack8(oh);
  }
}
struct TDat { uint4 a[4], b[4]; };
DEV void T_issue(TDat& R, int tid, const u16* src, size_t ld) {
  const int jp = tid & 63, cgp = tid >> 6;
  const u16* s0 = src + (size_t)(2 * jp) * ld + cgp * 32;
  const u16* s1 = s0 + ld;
#pragma unroll
  for (int h = 0; h < 4; ++h) { R.a[h] = *(const uint4*)(s0 + h * 8); R.b[h] = *(const uint4*)(s1 + h * 8); }
}
DEV void T_commit(const TDat& R, int tid, char* sT) {
  const int jp = tid & 63, cgp = tid >> 6;
  const int cb = jp >> 2, bo = (jp & 3) * 4;
#pragma unroll
  for (int h = 0; h < 4; ++h) {
    float fa[8], fb[8];
    unpack8(R.a[h], fa); unpack8(R.b[h], fb);
#pragma unroll
    for (int e = 0; e < 8; ++e) {
      const int c = cgp * 32 + h * 8 + e;
      *(unsigned*)(sT + toff16(c, cb) + bo) = pk(fa[e], fb[e]);
    }
  }
}

__device__ void phase2(const P& p, char* smem) {
  smem += VHALF * 65536;
  const u16* Z = (const u16*)(p.ws + ZB);
  u16* YB = (u16*)(p.ws + YBO);
  const float* cosT = (const float*)(p.ws + ROPEC);
  const float* sinT = (const float*)(p.ws + ROPES);
  float* out = p.out;
  for (int item = VBLK; item < 2048; item += VGRD) {
    int tid = VT;
    asm volatile("" : "+v"(tid));
    const int lane = tid & 63, w = tid >> 6, wm = w >> 1, wn = w & 1, r = lane & 15, q = lane >> 4;
    if (item < 512) {
      const int b = item >> 6, h = (item >> 4) & 3, c = item & 15;
      const size_t R0 = (size_t)b * 2048 + c * 128;
      const float lg = lgh(h);
      char* sV = smem; char* sK = smem + 32768;
      {
        const int jp = tid & 63;
        const float z0 = expf((127.f - 2.f * jp) * lg), z1 = expf((126.f - 2.f * jp) * lg);
        load_T(tid, sV, Z + R0 * 3072 + 1024 + h * 128, 3072, [=](int which, int, float v) { return v * (which ? z1 : z0); });
      }
      load_rot_T(tid, sK, Z + R0 * 3072 + 512 + h * 128, 3072, cosT + (size_t)c * 128 * 64, sinT + (size_t)c * 128 * 64);
      __syncthreads();
      f32x4 acc[4][4];
      zero_acc(acc);
      mma_tile<16>(acc, sV, sK, wm, wn, lane);
      u16* uc = (u16*)(p.ws + UCO) + (size_t)item * 16384;
#pragma unroll
      for (int mi = 0; mi < 4; ++mi)
#pragma unroll
        for (int ni = 0; ni < 4; ++ni) {
          int e = wm * 64 + mi * 16 + r, d = wn * 64 + ni * 16 + q * 4;
          *(uint2*)(uc + e * 128 + d) = make_uint2(pk(acc[mi][ni][0], acc[mi][ni][1]), pk(acc[mi][ni][2], acc[mi][ni][3]));
        }
      __syncthreads();
    } else if (item < 1536) {
      const int it = item - 512, b = it >> 7, c = (it >> 3) & 15, n = it & 7;
      const size_t R0 = (size_t)b * 2048 + c * 128;
      char* sX = smem;
      char* sA = smem + 32768; char* sB = smem + 49152;
      char* sBv = smem + 32768;
      {
        const int t = tid >> 1, half = tid & 1, ch0 = n * 64 + half * 32;
        float xc[32];
#pragma unroll
        for (int k = 0; k < 8; ++k) {
          float4 v = *(const float4*)(p.conv_b + ch0 + k * 4);
          xc[k * 4] = v.x; xc[k * 4 + 1] = v.y; xc[k * 4 + 2] = v.z; xc[k * 4 + 3] = v.w;
        }
#pragma unroll
        for (int j = 0; j < 4; ++j) {
          int tt = c * 128 + t - 3 + j;
          if (tt >= 0) {
            const u16* s = Z + ((size_t)b * 2048 + tt) * 3072 + 2048 + ch0;
            const float* cw = p.conv_w + j * 512 + ch0;
#pragma unroll
            for (int hh = 0; hh < 4; ++hh) {
              float x[8];
              unpack8(*(const uint4*)(s + hh * 8), x);
              float4 w0 = *(const float4*)(cw + hh * 8), w1 = *(const float4*)(cw + hh * 8 + 4);
              xc[hh * 8 + 0] += w0.x * x[0]; xc[hh * 8 + 1] += w0.y * x[1]; xc[hh * 8 + 2] += w0.z * x[2]; xc[hh * 8 + 3] += w0.w * x[3];
              xc[hh * 8 + 4] += w1.x * x[4]; xc[hh * 8 + 5] += w1.y * x[5]; xc[hh * 8 + 6] += w1.z * x[6]; xc[hh * 8 + 7] += w1.w * x[7];
            }
          }
        }
#pragma unroll
        for (int k = 0; k < 8; ++k)
          *(float4*)(sX + xoff(t, half * 32 + k * 4)) = make_float4(xc[k * 4], xc[k * 4 + 1], xc[k * 4 + 2], xc[k * 4 + 3]);
#pragma unroll
        for (int hh = 0; hh < 4; ++hh) *(uint4*)(sA + toff8(t, half * 4 + hh)) = pack8(xc + hh * 8);
      }
      {
        const int d = tid & 63, cgp = tid >> 6;
        const float* wa = p.lru_wa + (size_t)n * 4096 + d;
        const float* wx = p.lru_wx + (size_t)n * 4096 + d;
        float fa[16], fx[16];
#pragma unroll
        for (int k = 0; k < 16; ++k) { fa[k] = wa[(cgp * 16 + k) * 64]; fx[k] = wx[(cgp * 16 + k) * 64]; }
        const int rowA = (d >> 5) * 64 + ((d >> 4) & 1) * 32 + (d & 15), rowX = rowA + 16;
        *(uint4*)(sB + toff8(rowA, cgp * 2)) = pack8(fa);
        *(uint4*)(sB + toff8(rowA, cgp * 2 + 1)) = pack8(fa + 8);
        *(uint4*)(sB + toff8(rowX, cgp * 2)) = pack8(fx);
        *(uint4*)(sB + toff8(rowX, cgp * 2 + 1)) = pack8(fx + 8);
      }
      float bav2[2][4], bxv2[2][4], lav2[2][4];
#pragma unroll
      for (int pp = 0; pp < 2; ++pp) {
        const int chg = n * 64 + wn * 32 + pp * 16 + q * 4;
        const float4 ba = *(const float4*)(p.lru_ba + chg), bx = *(const float4*)(p.lru_bx + chg), lam = *(const float4*)(p.lru_lambda + chg);
        bav2[pp][0] = ba.x; bav2[pp][1] = ba.y; bav2[pp][2] = ba.z; bav2[pp][3] = ba.w;
        bxv2[pp][0] = bx.x; bxv2[pp][1] = bx.y; bxv2[pp][2] = bx.z; bxv2[pp][3] = bx.w;
        lav2[pp][0] = -8.f * log1pf(__expf(-lam.x)); lav2[pp][1] = -8.f * log1pf(__expf(-lam.y));
        lav2[pp][2] = -8.f * log1pf(__expf(-lam.z)); lav2[pp][3] = -8.f * log1pf(__expf(-lam.w));
      }
      __syncthreads();
      f32x4 acc[4][4];
      zero_acc(acc);
      mma_tile<8>(acc, sA, sB, wm, wn, lane);
#pragma unroll
      for (int mi = 0; mi < 4; ++mi)
#pragma unroll
        for (int pp = 0; pp < 2; ++pp) {
          const int t = wm * 64 + mi * 16 + r, chl = wn * 32 + pp * 16 + q * 4;
          float4 xv = *(const float4*)(sX + xoff(t, chl));
          const float* bav = bav2[pp]; const float* bxv = bxv2[pp]; const float* lav = lav2[pp];
          float xvv[4] = {xv.x, xv.y, xv.z, xv.w};
#pragma unroll
          for (int j = 0; j < 4; ++j) {
            float rr = sigmoidf_(acc[mi][2 * pp][j] + bav[j]);
            float ii = sigmoidf_(acc[mi][2 * pp + 1][j] + bxv[j]);
            float la = rr * lav[j];
            float a = __expf(la);
            float mult = sqrtf(fmaxf(1.f - a * a, 0.f));
            acc[mi][2 * pp][j] = a;
            acc[mi][2 * pp + 1][j] = xvv[j] * ii * mult;
          }
        }
      __syncthreads();
#pragma unroll
      for (int mi = 0; mi < 4; ++mi)
#pragma unroll
        for (int pp = 0; pp < 2; ++pp) {
          const int t = wm * 64 + mi * 16 + r, chl = wn * 32 + pp * 16 + q * 4;
          *(f32x4*)(sX + xoff(t, chl)) = acc[mi][2 * pp];
          *(f32x4*)(sBv + xoff(t, chl)) = acc[mi][2 * pp + 1];
        }
      __syncthreads();
      {
        const int ch = lane, t0 = w * 32;
        float hl_[32], pl_[32];
        float hh = 0.f, pq = 1.f;
#pragma unroll
        for (int t = 0; t < 32; ++t) {
          const float a = *(const float*)(sX + xoff(t0 + t, ch)), bb = *(const float*)(sBv + xoff(t0 + t, ch));
          hh = a * hh + bb;
          pq *= a;
          hl_[t] = hh; pl_[t] = pq;
        }
        __syncthreads();
        float* carry = (float*)sX;
        carry[(w * 2 + 0) * 64 + ch] = pq;
        carry[(w * 2 + 1) * 64 + ch] = hh;
        __syncthreads();
        float hin = 0.f, pin = 1.f;
#pragma unroll
        for (int ww = 0; ww < 3; ++ww) {
          if (ww < w) {
            const float pw = carry[(ww * 2 + 0) * 64 + ch], hw = carry[(ww * 2 + 1) * 64 + ch];
            hin = pw * hin + hw;
            pin *= pw;
          }
        }
        u16* hl = (u16*)out + (R0 + t0) * 512 + n * 64 + ch;
        u16* pl = (u16*)out + 8388608 + (R0 + t0) * 512 + n * 64 + ch;
#pragma unroll
        for (int t = 0; t < 32; ++t) {
          hl[(size_t)t * 512] = f2bf(hl_[t] + pl_[t] * hin);
          pl[(size_t)t * 512] = f2bf(pl_[t] * pin);
        }
        if (w == 3) {
          ((float*)(p.ws + AGGP))[(b * 16 + c) * 512 + n * 64 + ch] = pl_[31] * pin;
          ((float*)(p.ws + AGGH))[(b * 16 + c) * 512 + n * 64 + ch] = hl_[31] + pl_[31] * hin;
        }
      }
      __syncthreads();
    } else {
      const int it = item - 1536, b = it >> 2, h = it & 3;
      const size_t row = MP + b;
      float* sq = (float*)smem; float* sk = sq + 128; float* sv = sq + 256; float* red = sq + 384;
      float4 s0v[16];
      {
        const float* S0p = p.state_ret + ((size_t)(b * 4 + h) * 128) * 128 + (tid >> 5) * 16 * 128 + (tid & 31) * 4;
#pragma unroll
        for (int dd = 0; dd < 16; ++dd) s0v[dd] = *(const float4*)(S0p + dd * 128);
      }
      if (tid < 128) {
        const int d = tid, dl = d & 63;
        const float cc = cosT[2048 * 64 + dl], sn = sinT[2048 * 64 + dl];
        const u16* zr = Z + row * 3072 + h * 128;
        float q1 = bf(zr[dl]), q2 = bf(zr[dl + 64]), k1 = bf(zr[512 + dl]), k2 = bf(zr[512 + dl + 64]);
        float qo = d < 64 ? q1 * cc - q2 * sn : q2 * cc + q1 * sn;
        float ko = d < 64 ? k1 * cc - k2 * sn : k2 * cc + k1 * sn;
        sq[d] = qo * 0.08838834764831845f; sk[d] = ko; sv[d] = bf(zr[1024 + d]);
      }
      __syncthreads();
      {
        const float gamma = 1.f - exp2f(-5.f - (float)h);
        const int e4 = tid & 31, dg = tid >> 5;
        const size_t so = ((size_t)(b * 4 + h) * 128) * 128;
        const float* S0 = p.state_ret + so;
        float* Sn = out + O_RETS + so;
        const float4 v4 = *(const float4*)(sv + e4 * 4);
        float4 o = make_float4(0.f, 0.f, 0.f, 0.f);
#pragma unroll
        for (int dd = 0; dd < 16; ++dd) {
          const int d = dg * 16 + dd;
          const float4 s0 = s0v[dd];
          const float kd = sk[d], qd = sq[d];
          float4 s1;
          s1.x = gamma * s0.x + kd * v4.x; s1.y = gamma * s0.y + kd * v4.y; s1.z = gamma * s0.z + kd * v4.z; s1.w = gamma * s0.w + kd * v4.w;
          *(float4*)(Sn + d * 128 + e4 * 4) = s1;
          o.x += qd * s1.x; o.y += qd * s1.y; o.z += qd * s1.z; o.w += qd * s1.w;
        }
        *(float4*)(red + dg * 128 + e4 * 4) = o;
      }
      __syncthreads();
      if (tid < 64) {
        float o1 = 0.f, o2 = 0.f;
#pragma unroll
        for (int dg = 0; dg < 8; ++dg) { o1 += red[dg * 128 + tid]; o2 += red[dg * 128 + 64 + tid]; }
        const float mean = wave_sum(o1 + o2) * (1.f / 128.f);
        const float d1 = o1 - mean, d2 = o2 - mean;
        const float var = wave_sum(d1 * d1 + d2 * d2) * (1.f / 128.f);
        const float rs = rsqrtf(var + EPS);
        const u16* zg = Z + row * 3072 + 1536 + h * 128;
        const float g1 = bf(zg[tid]), g2 = bf(zg[tid + 64]);
        YB[row * 1024 + h * 128 + tid] = f2bf(d1 * rs * p.ret_gn[h * 128 + tid] * siluf_(g1));
        YB[row * 1024 + h * 128 + 64 + tid] = f2bf(d2 * rs * p.ret_gn[h * 128 + 64 + tid] * siluf_(g2));
      }
      __syncthreads();
      if (h < 2) {
        float* xs = (float*)(smem + 8192);
        const int ch = h * 256 + tid;
        {
          const float x = bf(Z[row * 3072 + 2048 + ch]);
          const float b0 = p.state_conv[(b * 3 + 0) * 512 + ch], b1 = p.state_conv[(b * 3 + 1) * 512 + ch], b2 = p.state_conv[(b * 3 + 2) * 512 + ch];
          xs[tid] = p.conv_b[ch] + p.conv_w[ch] * b0 + p.conv_w[512 + ch] * b1 + p.conv_w[1024 + ch] * b2 + p.conv_w[1536 + ch] * x;
          out[O_CONVS + (b * 3 + 0) * 512 + ch] = b1;
          out[O_CONVS + (b * 3 + 1) * 512 + ch] = b2;
          out[O_CONVS + (b * 3 + 2) * 512 + ch] = x;
        }
        __syncthreads();
        {
          const int n = ch >> 6, d = ch & 63;
          float racc = p.lru_ba[ch], iacc = p.lru_bx[ch];
          const float* wa = p.lru_wa + (size_t)n * 4096 + d;
          const float* wx = p.lru_wx + (size_t)n * 4096 + d;
#pragma unroll 16
          for (int cc = 0; cc < 64; ++cc) {
            const float xv = xs[(n & 3) * 64 + cc];
            racc += xv * wa[cc * 64];
            iacc += xv * wx[cc * 64];
          }
          const float rr = sigmoidf_(racc), ii = sigmoidf_(iacc);
          const float la = -8.f * rr * log1pf(expf(-p.lru_lambda[ch]));
          const float a = expf(la), mult = sqrtf(-expm1f(2.f * la));
          const float hv = a * p.state_lru[b * 512 + ch] + mult * ii * xs[tid];
          out[O_LRUS + b * 512 + ch] = hv;
          const float gb = bf(Z[row * 3072 + 2560 + ch]);
          YB[row * 1024 + 512 + ch] = f2bf(hv * geluf_(gb));
        }
        __syncthreads();
      }
    }
  }
  for (int idx = blockIdx.x * blockDim.x + threadIdx.x; idx < 12288; idx += gridDim.x * blockDim.x) {
    const int b = idx / 1536, j = (idx / 512) % 3, ch = idx & 511;
    out[O_CONVP + idx] = bf(Z[((size_t)b * 2048 + 2045 + j) * 3072 + 2048 + ch]);
  }
}

__device__ void phase3(const P& p) {
  const int gt = blockIdx.x * blockDim.x + threadIdx.x, gn = gridDim.x * blockDim.x;
  const u16* Z = (const u16*)(p.ws + ZB);
  u16* YB = (u16*)(p.ws + YBO);
  float* out = p.out;
  {
    const u16* UC = (const u16*)(p.ws + UCO);
    u16* SST = (u16*)(p.ws + SSTO);
    for (int v = gt; v < 131072; v += gn) {
      const int bh = v >> 12, idx4 = (v & 4095) * 4, e = idx4 >> 7, d = idx4 & 127;
      const float g128 = expf(128.f * lgh(bh & 3));
      float4 s = make_float4(0.f, 0.f, 0.f, 0.f);
      uint2 uu[16];
#pragma unroll
      for (int c = 0; c < 16; ++c) uu[c] = *(const uint2*)(UC + ((size_t)(bh * 16 + c)) * 16384 + idx4);
#pragma unroll
      for (int c = 0; c < 16; ++c) {
        const size_t o = ((size_t)(bh * 16 + c)) * 16384 + idx4;
        *(uint2*)(SST + o) = make_uint2(pk(s.x, s.y), pk(s.z, s.w));
        const float4 u = make_float4(blo(uu[c].x), bhi(uu[c].x), blo(uu[c].y), bhi(uu[c].y));
        s.x = g128 * s.x + u.x; s.y = g128 * s.y + u.y; s.z = g128 * s.z + u.z; s.w = g128 * s.w + u.w;
      }
      float* o = out + O_RETP + ((size_t)bh * 128 + d) * 128 + e;
      o[0] = s.x; o[128] = s.y; o[256] = s.z; o[384] = s.w;
    }
  }
  {
    const float* aggP = (const float*)(p.ws + AGGP);
    const float* aggH = (const float*)(p.ws + AGGH);
    for (int v = gt; v < 131072; v += gn) {
      const int ch = (v & 127) * 4, rg = (v >> 7) & 7, c = (v >> 10) & 15, b = v >> 14;
      float4 hs = make_float4(0.f, 0.f, 0.f, 0.f);
#pragma unroll
      for (int cc = 0; cc < 15; ++cc) {
        if (cc < c) {
          float4 pp = *(const float4*)(aggP + (b * 16 + cc) * 512 + ch), hh = *(const float4*)(aggH + (b * 16 + cc) * 512 + ch);
          hs.x = pp.x * hs.x + hh.x; hs.y = pp.y * hs.y + hh.y; hs.z = pp.z * hs.z + hh.z; hs.w = pp.w * hs.w + hh.w;
        }
      }
      const int row0 = b * 2048 + c * 128 + rg * 16;
#pragma unroll 8
      for (int i = 0; i < 16; ++i) {
        const int row = row0 + i;
        const uint2 hl2 = *(const uint2*)((const u16*)out + (size_t)row * 512 + ch), pq2 = *(const uint2*)((const u16*)out + 8388608 + (size_t)row * 512 + ch);
        const float4 hl = make_float4(blo(hl2.x), bhi(hl2.x), blo(hl2.y), bhi(hl2.y)), pq = make_float4(blo(pq2.x), bhi(pq2.x), blo(pq2.y), bhi(pq2.y));
        float4 hv;
        hv.x = hl.x + pq.x * hs.x; hv.y = hl.y + pq.y * hs.y; hv.z = hl.z + pq.z * hs.z; hv.w = hl.w + pq.w * hs.w;
        uint2 g = *(const uint2*)(Z + (size_t)row * 3072 + 2560 + ch);
        *(uint2*)(YB + (size_t)row * 1024 + 512 + ch) =
            make_uint2(pk(hv.x * geluf_(blo(g.x)), hv.y * geluf_(bhi(g.x))), pk(hv.z * geluf_(blo(g.y)), hv.w * geluf_(bhi(g.y))));
        if ((row & 2047) == 2047) *(float4*)(out + O_LRUP + b * 512 + ch) = hv;
      }
    }
  }
}

__device__ void phase4(const P& p, char* smem) {
  smem += VHALF * 65536;
  const u16* Z = (const u16*)(p.ws + ZB);
  u16* YB = (u16*)(p.ws + YBO);
  const u16* SST = (const u16*)(p.ws + SSTO);
  const float* cosT = (const float*)(p.ws + ROPEC);
  const float* sinT = (const float*)(p.ws + ROPES);
  char* bufA = smem; char* bufB = smem + 32768;
  for (int item = VBLK; item < 512; item += VGRD) {
    int tid = VT;
    asm volatile("" : "+v"(tid));
    const int lane = tid & 63, w = tid >> 6, wm = w >> 1, wn = w & 1, r = lane & 15, q = lane >> 4;
    const int b = item >> 6, h = (item >> 4) & 3, c = item & 15;
    const size_t R0 = (size_t)b * 2048 + c * 128;
    const float lg = lgh(h);
    const float* cs = cosT + (size_t)c * 128 * 64;
    const float* sn = sinT + (size_t)c * 128 * 64;
    RotTab T;
    RotDat qd, kd;
    rot_tab_issue(T, tid, cs, sn);
    rot_dat_issue(qd, tid, Z + R0 * 3072 + h * 128, 3072);
    load_N(tid, bufB, SST + (size_t)item * 16384, 128);
    rot_commit(qd, T, tid, bufA, 0.08838834764831845f);
    rot_dat_issue(kd, tid, Z + R0 * 3072 + 512 + h * 128, 3072);
    __syncthreads();
    f32x4 acco[4][4];
    zero_acc(acco);
    mma_tile<16>(acco, bufA, bufB, wm, wn, lane);
#pragma unroll
    for (int mi = 0; mi < 4; ++mi) {
      const float xi = expf((float)(wm * 64 + mi * 16 + r + 1) * lg);
#pragma unroll
      for (int ni = 0; ni < 4; ++ni) acco[mi][ni] *= xi;
    }
    __syncthreads();
    rot_commit(kd, T, tid, bufB, 1.f);
    TDat vd;
    T_issue(vd, tid, Z + R0 * 3072 + 1024 + h * 128, 3072);
    __syncthreads();
    f32x4 accs[4][4];
    zero_acc(accs);
    mma_tile<16>(accs, bufA, bufB, wm, wn, lane);
    __syncthreads();
#pragma unroll
    for (int mi = 0; mi < 4; ++mi)
#pragma unroll
      for (int ni = 0; ni < 4; ++ni) {
        const int i = wm * 64 + mi * 16 + r, j0 = wn * 64 + ni * 16 + q * 4;
        float o[4];
#pragma unroll
        for (int j = 0; j < 4; ++j) {
          const int df = i - (j0 + j);
          o[j] = df >= 0 ? accs[mi][ni][j] * __expf((float)df * lg) : 0.f;
        }
        *(uint2*)(bufA + toff16(i, j0 >> 3) + (j0 & 7) * 2) = make_uint2(pk(o[0], o[1]), pk(o[2], o[3]));
      }
    T_commit(vd, tid, bufB);
    const int gi = tid >> 1, ghalf = tid & 1;
    const u16* zg = Z + (R0 + gi) * 3072 + 1536 + h * 128 + ghalf * 64;
    const float* gn = p.ret_gn + h * 128 + ghalf * 64;
    uint4 gq[8];
    float4 gn0[8], gn1[8];
#pragma unroll
    for (int k = 0; k < 8; ++k) { gq[k] = *(const uint4*)(zg + k * 8); gn0[k] = *(const float4*)(gn + k * 8); gn1[k] = *(const float4*)(gn + k * 8 + 4); }
    __syncthreads();
    mma_tile<16>(acco, bufA, bufB, wm, wn, lane);
    __syncthreads();
#pragma unroll
    for (int mi = 0; mi < 4; ++mi)
#pragma unroll
      for (int ni = 0; ni < 4; ++ni) {
        const int i = wm * 64 + mi * 16 + r, e = wn * 64 + ni * 16 + q * 4;
        *(f32x4*)(smem + ooff(i, e)) = acco[mi][ni];
      }
    __syncthreads();
    {
      const int i = gi, half = ghalf;
      float x[64];
      float s = 0.f;
#pragma unroll
      for (int k = 0; k < 16; ++k) {
        float4 v = *(const float4*)(smem + ooff(i, half * 64 + k * 4));
        x[k * 4] = v.x; x[k * 4 + 1] = v.y; x[k * 4 + 2] = v.z; x[k * 4 + 3] = v.w;
        s += v.x + v.y + v.z + v.w;
      }
      s += __shfl_xor(s, 1);
      const float mean = s * (1.f / 128.f);
      float vs = 0.f;
#pragma unroll
      for (int k = 0; k < 64; ++k) { x[k] -= mean; vs += x[k] * x[k]; }
      vs += __shfl_xor(vs, 1);
      const float rs = rsqrtf(vs * (1.f / 128.f) + EPS);
      u16* yo = YB + (R0 + i) * 1024 + h * 128 + half * 64;
#pragma unroll
      for (int k = 0; k < 8; ++k) {
        float g[8], o[8];
        unpack8(gq[k], g);
        const float4 g0 = gn0[k], g1 = gn1[k];
        float gv[8] = {g0.x, g0.y, g0.z, g0.w, g1.x, g1.y, g1.z, g1.w};
#pragma unroll
        for (int e = 0; e < 8; ++e) o[e] = x[k * 8 + e] * rs * gv[e] * siluf_(g[e]);
        *(uint4*)(yo + k * 8) = pack8(o);
      }
    }
    __syncthreads();
  }
}

__device__ void phase9(const P& p, char* smem) {
  smem += VHALF * 65536;
  const u16* UB = (const u16*)(p.ws + ZB);
  const u16* VB = (const u16*)(p.ws + ZB + 33816576);
  u16* YB = (u16*)(p.ws + YBO);
  const float* lns = (const float*)(p.ws + LNSO);
  const float* lnq = (const float*)(p.ws + LNQO);
  char* bufA = smem; char* bufB = smem + 32768;
  for (int item = VBLK; item < 1024 + 32; item += VGRD) {
    int tid = VT;
    asm volatile("" : "+v"(tid));
    const int lane = tid & 63, w = tid >> 6, wm = w >> 1, wn = w & 1, r = lane & 15, q = lane >> 4;
    if (item < 1024) {
      const int b = item >> 7, c = (item >> 3) & 15, g = item & 7;
      const size_t R0 = (size_t)b * 2048 + c * 128;
#pragma unroll
      for (int i = 0; i < 8; ++i) {
        int idx = tid + 256 * i, row = idx >> 4, ch = idx & 15;
        const float* s = p.sg_ws + ((size_t)(g * 128 + row)) * 128 + ch * 8;
        float4 a = *(const float4*)s, bq = *(const float4*)(s + 4);
        float f[8] = {a.x, a.y, a.z, a.w, bq.x, bq.y, bq.z, bq.w};
#pragma unroll
        for (int e = 0; e < 8; ++e) f[e] = (ch * 8 + e <= row) ? f[e] : 0.f;
        *(uint4*)(bufA + toff16(row, ch)) = pack8(f);
      }
      {
        const int jp = tid & 63;
        const int r0 = (int)R0 + 2 * jp;
        const float m0 = sum16(lns, r0) * (1.f / 1024.f), m1 = sum16(lns, r0 + 1) * (1.f / 1024.f);
        const float v0 = sum16(lnq, r0) * (1.f / 1024.f) - m0 * m0, v1 = sum16(lnq, r0 + 1) * (1.f / 1024.f) - m1 * m1;
        const float rs0 = rsqrtf(fmaxf(v0, 0.f) + EPS), rs1 = rsqrtf(fmaxf(v1, 0.f) + EPS);
        const float* vg = p.sg_norm_g + g * 128; const float* vb = p.sg_norm_b + g * 128;
        load_T_ln(tid, bufB, VB + R0 * 1024 + g * 128, 1024, m0, rs0, m1, rs1, vg, vb);
      }
      uint2 uu[4][4];
      float bsv[4];
#pragma unroll
      for (int mi = 0; mi < 4; ++mi) {
        const int i = wm * 64 + mi * 16 + r;
        bsv[mi] = p.sg_bs[g * 128 + i];
#pragma unroll
        for (int ni = 0; ni < 4; ++ni) uu[mi][ni] = *(const uint2*)(UB + (R0 + i) * 1024 + g * 128 + wn * 64 + ni * 16 + q * 4);
      }
      __syncthreads();
      f32x4 acc[4][4];
      zero_acc(acc);
      mma_tile<16>(acc, bufA, bufB, wm, wn, lane);
#pragma unroll
      for (int mi = 0; mi < 4; ++mi) {
        const int i = wm * 64 + mi * 16 + r;
        const float bs = bsv[mi];
#pragma unroll
        for (int ni = 0; ni < 4; ++ni) {
          const size_t o = (R0 + i) * 1024 + g * 128 + wn * 64 + ni * 16 + q * 4;
          const uint2 u = uu[mi][ni];
          f32x4 a = acc[mi][ni];
          *(uint2*)(YB + o) = make_uint2(pk(blo(u.x) * (a[0] + bs), bhi(u.x) * (a[1] + bs)), pk(blo(u.y) * (a[2] + bs), bhi(u.y) * (a[3] + bs)));
        }
      }
      __syncthreads();
    } else {
      const int row = MP + (item - 1024) * 4 + w;
      const float m = sum16(lns, row) * (1.f / 1024.f);
      const float var = sum16(lnq, row) * (1.f / 1024.f) - m * m;
      const float rs = rsqrtf(fmaxf(var, 0.f) + EPS);
#pragma unroll
      for (int i = 0; i < 4; ++i) {
        const int ch = (lane + 64 * i) * 4, g = ch >> 7;
        uint2 vv = *(const uint2*)(VB + (size_t)row * 1024 + ch), uu = *(const uint2*)(UB + (size_t)row * 1024 + ch);
        float4 gg = *(const float4*)(p.sg_norm_g + ch), bb = *(const float4*)(p.sg_norm_b + ch);
        float4 vn;
        vn.x = (blo(vv.x) - m) * rs * gg.x + bb.x; vn.y = (bhi(vv.x) - m) * rs * gg.y + bb.y;
        vn.z = (blo(vv.y) - m) * rs * gg.z + bb.z; vn.w = (bhi(vv.y) - m) * rs * gg.w + bb.w;
        *(float4*)(p.out + O_SGUV + (size_t)(row - MP) * 1024 + ch) = vn;
        const float w00 = p.sg_ws[(size_t)g * 16384], b0 = p.sg_bs[g * 128];
        *(uint2*)(YB + (size_t)row * 1024 + ch) =
            make_uint2(pk(blo(uu.x) * (w00 * vn.x + b0), bhi(uu.x) * (w00 * vn.y + b0)), pk(blo(uu.y) * (w00 * vn.z + b0), bhi(uu.y) * (w00 * vn.w + b0)));
      }
    }
  }
}

__device__ void phase13(const P& p) {
  const int lane = tidx_() & 63, w = VT >> 6;
  const u16* xb = (const u16*)(p.ws + XB);
  for (int item = VBLK; item < 2064; item += VGRD) {
    const int row0 = item * 8 + w * 2;
    uint4 v[2][2];
#pragma unroll
    for (int rr = 0; rr < 2; ++rr)
#pragma unroll
      for (int i = 0; i < 2; ++i) v[rr][i] = *(const uint4*)(xb + (size_t)(row0 + rr) * D + (lane + 64 * i) * 8);
#pragma unroll
    for (int rr = 0; rr < 2; ++rr) {
      float f[2][8];
      float ss = 0.f;
#pragma unroll
      for (int i = 0; i < 2; ++i) {
        unpack8(v[rr][i], f[i]);
#pragma unroll
        for (int j = 0; j < 8; ++j) ss += f[i][j] * f[i][j];
      }
      ss = wave_sum(ss);
      const float rs = rsqrtf(ss * (1.f / 1024.f) + EPS);
      float* y = p.out + (size_t)(row0 + rr) * D;
#pragma unroll
      for (int i = 0; i < 2; ++i) {
        const int c0 = (lane + 64 * i) * 8;
        const float4 g0 = *(const float4*)(p.norm_f + c0), g1 = *(const float4*)(p.norm_f + c0 + 4);
        *(float4*)(y + c0) = make_float4(f[i][0] * rs * g0.x, f[i][1] * rs * g0.y, f[i][2] * rs * g0.z, f[i][3] * rs * g0.w);
        *(float4*)(y + c0 + 4) = make_float4(f[i][4] * rs * g1.x, f[i][5] * rs * g1.y, f[i][6] * rs * g1.z, f[i][7] * rs * g1.w);
      }
    }
  }
}

template <int PH>
DEV void run_phase(const P& p, char* smem, int vx = -1, int vl = 0) {
  char* ws = p.ws;
  GArgs g{};
  g.resid = p.out;
  if (PH == 0) phase0(p, smem);
  else if (PH == 1) {
    g.A = (const u16*)(ws + XB); g.lda = 1024; g.B = (const u16*)(ws + W_INA); g.K = 1024; g.ntn = 24; g.PM = 8;
    g.ss = (const float*)(ws + SS0); g.o16 = (u16*)(ws + ZB);
    gemm_phase<EPI_INA>(p, g, smem);
  } else if (PH == 2) phase2(p, smem);
  else if (PH == 3) phase3(p);
  else if (PH == 4) phase4(p, smem);
  else if (PH == 5) {
    g.A = (const u16*)(ws + YBO); g.lda = 1024; g.B = (const u16*)(ws + W_OUTA); g.K = 1024; g.ntn = 8; g.PM = 8;
    g.ssw = (float*)(ws + SS0 + SSSZ); g.o16 = (u16*)(ws + XB);
    g.skip_sample = 1;
    gemm_phase<EPI_RES>(p, g, smem);
  } else if (PH == 6) {
    g.A = (const u16*)(ws + XB); g.lda = 1024; g.B = (const u16*)(ws + W_GU0); g.K = 1024; g.ntn = 44; g.PM = 16;
    g.ss = (const float*)(ws + SS0 + SSSZ); g.o16 = (u16*)(ws + ZB);
    GArgs g2{};
    g2.resid = p.out;
    g2.A = (const u16*)(ws + ZB); g2.lda = 2816; g2.B = (const u16*)(ws + W_D0); g2.K = 2816; g2.ntn = 8; g2.PM = 8;
    g2.ssw = (float*)(ws + SS0 + 2 * SSSZ); g2.o16 = (u16*)(ws + XB);
    GArgs g0{};
    g0.resid = p.out;
    g0.A = (const u16*)(ws + YBO); g0.lda = 1024; g0.B = (const u16*)(ws + W_OUTA); g0.K = 1024; g0.ntn = 8; g0.PM = 8;
    g0.ssw = (float*)(ws + SS0 + SSSZ); g0.o16 = (u16*)(ws + XB);
    g.prev = &g0; g.prev_in = 0;
    g.next = &g2; g.cnt = (unsigned*)(ws + BARO) + 32;
    g.wc_lo = 1568; g.wc_hi = 2656;
    g.wc2_lo = 2656; g.wc2_hi = 3008;
    gemm_phase<EPI_GU>(p, g, smem);
  } else if (PH == 7) {
    g.A = (const u16*)(ws + ZB); g.lda = 2816; g.B = (const u16*)(ws + W_D0); g.K = 2816; g.ntn = 8; g.PM = 8;
    g.ssw = (float*)(ws + SS0 + 2 * SSSZ); g.o16 = (u16*)(ws + XB); g.skip_sample = 1;
    gemm_phase<EPI_RES>(p, g, smem);
  } else if (PH == 8) {
    g.A = (const u16*)(ws + XB); g.lda = 1024; g.B = (const u16*)(ws + W_INC); g.K = 1024; g.ntn = 16; g.PM = 8;
    g.ss = (const float*)(ws + SS0 + 2 * SSSZ); g.o16 = (u16*)(ws + ZB); g.o16b = (u16*)(ws + ZB + 33816576);
    g.lns = (float*)(ws + LNSO); g.lnq = (float*)(ws + LNQO);
    gemm_phase<EPI_INC>(p, g, smem);
  } else if (PH == 9) phase9(p, smem);
  else if (PH == 10) {
    g.A = (const u16*)(ws + YBO); g.lda = 1024; g.B = (const u16*)(ws + W_OUTC); g.K = 1024; g.ntn = 8; g.PM = 8;
    g.ssw = (float*)(ws + SS0 + 3 * SSSZ); g.o16 = (u16*)(ws + XB);
    g.skip_sample = 1;
    gemm_phase<EPI_RES>(p, g, smem);
  } else if (PH == 11) {
    g.A = (const u16*)(ws + XB); g.lda = 1024; g.B = (const u16*)(ws + W_GU1); g.K = 1024; g.ntn = 44; g.PM = 16;
    g.ss = (const float*)(ws + SS0 + 3 * SSSZ); g.o16 = (u16*)(ws + ZB);
    GArgs g2{};
    g2.resid = p.out;
    g2.A = (const u16*)(ws + ZB); g2.lda = 2816; g2.B = (const u16*)(ws + W_D1); g2.K = 2816; g2.ntn = 8; g2.PM = 8;
    g2.ssw = (float*)(ws + SS0 + 4 * SSSZ); g2.o16 = (u16*)(ws + XB);
    GArgs g0{};
    g0.resid = p.out;
    g0.A = (const u16*)(ws + YBO); g0.lda = 1024; g0.B = (const u16*)(ws + W_OUTC); g0.K = 1024; g0.ntn = 8; g0.PM = 8;
    g0.ssw = (float*)(ws + SS0 + 3 * SSSZ); g0.o16 = (u16*)(ws + XB);
    g.prev = &g0; g.prev_in = 0;
    g.next = &g2; g.cnt = (unsigned*)(ws + BARO) + 64;
    g.wc_lo = 0; g.wc_hi = 0;
    gemm_phase<EPI_GU>(p, g, smem);
  } else if (PH == 12) {
    g.A = (const u16*)(ws + ZB); g.lda = 2816; g.B = (const u16*)(ws + W_D1); g.K = 2816; g.ntn = 8; g.PM = 8;
    g.ssw = (float*)(ws + SS0 + 4 * SSSZ); g.o16 = (u16*)(ws + XB); g.skip_sample = 1;
    gemm_phase<EPI_RES>(p, g, smem);
  } else if (PH == 13) phase13(p);
}

#if FUSED
#define XB_TMO      128
#define XB_XCNT(j)  (256  + 64 * (j))
#define XB_XSUB(j)  (1280 + 64 * (j))
#define XB_XGEN(j)  (2304 + 64 * (j))
#define XB_TOP      3328
#define XB_TOPGEN   3392
#define XCD_BAR_WORDS 3456
#define XB_SPIN_CAP (1u << 22)
DEV unsigned xb_ld(unsigned* p) { return __hip_atomic_load(p, __ATOMIC_RELAXED, __HIP_MEMORY_SCOPE_AGENT); }
DEV unsigned xb_add(unsigned* p, unsigned v) { return __hip_atomic_fetch_add(p, v, __ATOMIC_RELAXED, __HIP_MEMORY_SCOPE_AGENT); }
DEV unsigned xb_xcc_id() { return (unsigned)__builtin_amdgcn_s_getreg((3 << 11) | 20) & 0xFu; }
#define XB_SPIN(cond, bar) do { unsigned _sp = 0; while (cond) { __builtin_amdgcn_s_sleep(1); \
    if ((++_sp & 255u) == 0u) { if (xb_ld(&(bar)[XB_TMO])) break; if (_sp > XB_SPIN_CAP) { atomicAdd(&(bar)[XB_TMO], 1u); break; } } } } while (0)
DEV void xb_complete(unsigned* bar, unsigned x, unsigned& nloc, unsigned& nx, unsigned& even) {
  const unsigned G = gridDim.x;
  unsigned sum, cnt, mine, sp = 0u;
  for (;;) {
    sum = 0u; cnt = 0u; mine = 0u; even = 1u;
#pragma unroll
    for (unsigned j = 0; j < 16; ++j) { const unsigned c = xb_ld(&bar[XB_XCNT(j)]); sum += c; cnt += (c > 0u) ? 1u : 0u; mine = (j == x) ? c : mine;
      if (j < 8 ? (c * 8u != G) : (c != 0u)) even = 0u; }
    if (sum == G) break;
    __builtin_amdgcn_s_sleep(1);
    if ((++sp & 255u) == 0u) { if (xb_ld(&bar[XB_TMO])) break; if (sp > XB_SPIN_CAP) { atomicAdd(&bar[XB_TMO], 1u); break; } }
  }
  nloc = mine > 0u ? mine : 1u; nx = cnt > 0u ? cnt : 1u;
}
DEV void gbar(unsigned* bar, unsigned x, unsigned& nloc, unsigned& nx, unsigned* evenp = nullptr) {
  asm volatile("s_waitcnt vmcnt(0)" ::: "memory");
  __syncthreads();
  if (threadIdx.x == 0) {
    __builtin_amdgcn_s_waitcnt(0);
    if (nloc == 0u) { unsigned ev; xb_complete(bar, x, nloc, nx, ev); if (evenp) *evenp = ev; }
    const unsigned old = xb_add(&bar[XB_XSUB(x)], 1u);
    const unsigned gen = old / nloc;
    if (old + 1u == (gen + 1u) * nloc) {
      __builtin_amdgcn_fence(__ATOMIC_RELEASE, "agent");
      asm volatile("s_waitcnt vmcnt(0)" ::: "memory");
      const unsigned og = xb_add(&bar[XB_TOP], 1u);
      const unsigned tg = og / nx;
      if (og + 1u == (tg + 1u) * nx) xb_add(&bar[XB_TOPGEN], 1u);
      else XB_SPIN(xb_ld(&bar[XB_TOPGEN]) == tg, bar);
      __builtin_amdgcn_fence(__ATOMIC_ACQUIRE, "agent");
      xb_add(&bar[XB_XGEN(x)], 1u);
      asm volatile("s_waitcnt vmcnt(0)" ::: "memory");
    } else {
      XB_SPIN(xb_ld(&bar[XB_XGEN(x)]) == gen, bar);
      __builtin_amdgcn_fence(__ATOMIC_ACQUIRE, "agent");
      asm volatile("s_waitcnt vmcnt(0)" ::: "memory");
    }
  }
  __syncthreads();
}
__global__ void __launch_bounds__(512, 2) mega(P p) {
  extern __shared__ __attribute__((aligned(16))) char smem[];
  cg::grid_group grid = cg::this_grid();
  unsigned* bar = (unsigned*)(p.ws + BARO);
  const unsigned xcc = xb_xcc_id();
  unsigned nloc = 0u, nx = 0u;
  if (threadIdx.x == 0) ((unsigned*)smem)[32767] = xb_add(&bar[XB_XCNT(xcc)], 1u);
  if (p.ws == nullptr) grid.sync();
  __syncthreads();
  const int rank = (int)((unsigned*)smem)[32767];
  __syncthreads();
  run_phase<0>(p, smem);
  gbar(bar, xcc, nloc, nx, (unsigned*)smem + 32766);
  const bool even = ((unsigned*)smem)[32766] != 0u;
  __syncthreads();
  const int vx = even ? (int)xcc : -1, vl = rank;
  run_phase<1>(p, smem, vx, vl); gbar(bar, xcc, nloc, nx);
  run_phase<2>(p, smem); gbar(bar, xcc, nloc, nx);
  run_phase<3>(p, smem); gbar(bar, xcc, nloc, nx);
  run_phase<4>(p, smem); gbar(bar, xcc, nloc, nx);
  run_phase<5>(p, smem, vx, vl); gbar(bar, xcc, nloc, nx);
  run_phase<6>(p, smem, vx, vl); gbar(bar, xcc, nloc, nx);
  run_phase<7>(p, smem, vx, vl); gbar(bar, xcc, nloc, nx);
  run_phase<8>(p, smem, vx, vl); gbar(bar, xcc, nloc, nx);
  run_phase<9>(p, smem); gbar(bar, xcc, nloc, nx);
  run_phase<10>(p, smem, vx, vl); gbar(bar, xcc, nloc, nx);
  run_phase<11>(p, smem, vx, vl); gbar(bar, xcc, nloc, nx);
  run_phase<12>(p, smem, vx, vl); gbar(bar, xcc, nloc, nx);
  run_phase<13>(p, smem);
}
#else
template <int PH>
__global__ void __launch_bounds__(256, 2) phase_kernel(P p) {
  __shared__ __attribute__((aligned(16))) char smem[65536];
  run_phase<PH>(p, smem);
}
#endif

extern "C" void kernel_launch(void* const* d_in, const int* in_sizes, int n_in, void* d_out, int out_size, void* d_ws,
                              size_t ws_size, hipStream_t stream) {
  P p{};
  const float** f = (const float**)&p;
  for (int i = 0; i < 27; ++i) f[i] = (const float*)d_in[i];
  p.out = (float*)d_out;
  p.ws = (char*)d_ws;
#if FUSED
  static int grid_blocks = 0;
  if (!grid_blocks) {
    int dev = 0, cus = 0, per_cu = 0;
    hipGetDevice(&dev);
    hipDeviceGetAttribute(&cus, hipDeviceAttributeMultiprocessorCount, dev);
    hipFuncSetAttribute((const void*)mega, hipFuncAttributeMaxDynamicSharedMemorySize, 131072 + 8192);
    hipOccupancyMaxActiveBlocksPerMultiprocessor(&per_cu, mega, 512, 131072 + 8192);
    if (per_cu > 1) per_cu = 1;
    grid_blocks = cus * per_cu;
  }
  hipMemsetAsync((char*)d_ws + BARO, 0, XCD_BAR_WORDS * 4, stream);
  void* args[] = {&p};
  hipError_t e = hipLaunchCooperativeKernel((void*)mega, dim3(grid_blocks), dim3(512), args, 131072 + 8192, stream);
  if (e != hipSuccess) fprintf(stderr, "cooperative launch failed: %s (grid %d)\n", hipGetErrorString(e), grid_blocks);
#else
  const int G = 512;
  phase_kernel<0><<<G, 256, 0, stream>>>(p);
  phase_kernel<1><<<G, 256, 0, stream>>>(p);
  phase_kernel<2><<<G, 256, 0, stream>>>(p);
  phase_kernel<3><<<G, 256, 0, stream>>>(p);
  phase_kernel<4><<<G, 256, 0, stream>>>(p);
  phase_kernel<5><<<G, 256, 0, stream>>>(p);
  phase_kernel<6><<<G, 256, 0, stream>>>(p);
  phase_kernel<7><<<G, 256, 0, stream>>>(p);
  phase_kernel<8><<<G, 256, 0, stream>>>(p);
  phase_kernel<9><<<G, 256, 0, stream>>>(p);
  phase_kernel<10><<<G, 256, 0, stream>>>(p);
  phase_kernel<11><<<G, 256, 0, stream>>>(p);
  phase_kernel<12><<<G, 256, 0, stream>>>(p);
  phase_kernel<13><<<G, 256, 0, stream>>>(p);
#endif
}
```
